# Optimizing an MI355X kernel written in HIP

```python
import jax, jax.numpy as jnp
from jax import lax
import numpy as np

D_MODEL = 1024
BATCH = 8
SEQ = 8192
DEPTH = 2

N_MIXERS = 2
N_RWKV = (DEPTH + 1) // 2
N_SGU = DEPTH // 2
RWKV_HEAD_DIM = 64
RWKV_HEADS = D_MODEL // RWKV_HEAD_DIM
DECAY_LORA = 64
AAA_LORA = 64
GATE_LORA = 128
RWKV_GN_EPS = 64e-5
CHUNK = 128
SGU_WIDTH = D_MODEL
SGU_GROUPS = 16
SGU_GROUP_DIM = SGU_WIDTH // SGU_GROUPS
SGU_LN_EPS = 1e-5
MEM_TOKENS = 256
XATTN_HEADS = 4
XATTN_HEAD_DIM = D_MODEL // XATTN_HEADS
FFN_WIDTH = 2816
CONV_WIDTH = 3
RMS_EPS = 1e-6

kernel_name = "rwkv7_sgu_interleaved_hybrid"


def rmsnorm(x, g):
    x32 = x.astype(jnp.float32)
    y = x32 * lax.rsqrt(jnp.mean(x32 * x32, axis=-1, keepdims=True) + RMS_EPS)
    return (y * g.astype(jnp.float32)).astype(x.dtype)


def wkv7_scan(r, w, k, v, kk, a):
    bsz, _, nh, nd = r.shape
    seq_first = [jnp.moveaxis(t.astype(jnp.float32), 1, 0) for t in (r, w, k, v, kk, a)]

    def step(state, inp):
        r_t, w_t, k_t, v_t, kk_t, a_t = inp
        sa = jnp.einsum('bhvk,bhk->bhv', state, kk_t)
        state = (state * w_t[:, :, None, :]
                 - sa[..., None] * (kk_t * a_t)[:, :, None, :]
                 + v_t[..., None] * k_t[:, :, None, :])
        return state, jnp.einsum('bhvk,bhk->bhv', state, r_t)

    init = jnp.zeros((bsz, nh, nd, nd), jnp.float32)
    _, out = lax.scan(step, init, tuple(seq_first))
    return jnp.moveaxis(out, 0, 1)


def rwkv7_time_mix(h, mu, w_rkv, w0, w1, w2, a0, a1, a2, g1, g2, k_k, k_a, r_k, lnx_g, lnx_b, w_o):
    bsz, seq, dm = h.shape
    heads = lambda t: t.reshape(bsz, seq, RWKV_HEADS, RWKV_HEAD_DIM)
    dx = jnp.pad(h, ((0, 0), (1, 0), (0, 0)))[:, :-1] - h
    xr, xw, xk, xv, xa, xg = [h + dx * mu[j] for j in range(6)]
    r = xr @ w_rkv[0]
    k = xk @ w_rkv[1]
    v = xv @ w_rkv[2]
    w_log = -jax.nn.softplus(-(w0 + jnp.tanh(xw @ w1) @ w2)) - 0.5
    decay = jnp.exp(-jnp.exp(w_log.astype(jnp.float32)))
    a = jax.nn.sigmoid(a0 + (xa @ a1) @ a2)
    g = jax.nn.sigmoid(xg @ g1) @ g2
    kk32 = heads(k * k_k).astype(jnp.float32)
    kk = kk32 / jnp.maximum(jnp.linalg.norm(kk32, axis=-1, keepdims=True), 1e-12)
    k = k * (1 + (a - 1) * k_a)
    o = wkv7_scan(heads(r), heads(decay), heads(k), heads(v), kk, heads(a))
    mean = jnp.mean(o, axis=-1, keepdims=True)
    var = jnp.mean(jnp.square(o - mean), axis=-1, keepdims=True)
    o = ((o - mean) * lax.rsqrt(var + RWKV_GN_EPS)).reshape(bsz, seq, dm)
    o = o * lnx_g.astype(jnp.float32) + lnx_b.astype(jnp.float32)
    bonus = jnp.sum(heads(r) * heads(k) * r_k, axis=-1, keepdims=True) * heads(v)
    o = o + bonus.reshape(bsz, seq, dm)
    return (o * g).astype(h.dtype) @ w_o


def chunked_sgu_mixer(h, w_in, ln_g, ln_b, w_s, b_s, w_out):
    bsz, seq, _ = h.shape
    z = jax.nn.gelu(h @ w_in)
    u, v = jnp.split(z, 2, axis=-1)
    v32 = v.astype(jnp.float32)
    mean = jnp.mean(v32, axis=-1, keepdims=True)
    var = jnp.mean(jnp.square(v32 - mean), axis=-1, keepdims=True)
    v = ((v32 - mean) * lax.rsqrt(var + SGU_LN_EPS) * ln_g + ln_b).astype(h.dtype)
    v = v.reshape(bsz, seq // CHUNK, CHUNK, SGU_GROUPS, SGU_GROUP_DIM)
    causal = jnp.tril(jnp.ones((CHUNK, CHUNK), dtype=bool))
    w_causal = jnp.where(causal[None], w_s, jnp.zeros_like(w_s))
    mixed = jnp.einsum('gts,bcsgd->bctgd', w_causal, v) + b_s.T[:, :, None]
    return (u * mixed.reshape(bsz, seq, SGU_WIDTH)) @ w_out


def memory_cross_attention(h, mem_n, w_q, w_kv, w_o):
    bsz, seq, dm = h.shape
    q = (h @ w_q).reshape(bsz, seq, XATTN_HEADS, XATTN_HEAD_DIM)
    k, v = jnp.split(mem_n @ w_kv, 2, axis=-1)
    k = k.reshape(bsz, -1, XATTN_HEADS, XATTN_HEAD_DIM)
    v = v.reshape(bsz, -1, XATTN_HEADS, XATTN_HEAD_DIM)
    s = jnp.einsum('bshd,bmhd->bhsm', q, k).astype(jnp.float32) * (XATTN_HEAD_DIM ** -0.5)
    p = jax.nn.softmax(s, axis=-1).astype(h.dtype)
    o = jnp.einsum('bhsm,bmhd->bshd', p, v).reshape(bsz, seq, dm)
    return o @ w_o


def conv_glu_ffn(h, w_up, conv_w, conv_b, w_down):
    seq = h.shape[1]
    gate, val = jnp.split(h @ w_up, 2, axis=-1)
    gp = jnp.pad(gate, ((0, 0), (CONV_WIDTH - 1, 0), (0, 0)))
    conv = sum(gp[:, j:j + seq] * conv_w[j] for j in range(CONV_WIDTH)) + conv_b
    return (jax.nn.silu(conv) * val) @ w_down


def setup_inputs(seed: int = 0) -> dict:
    key = jax.random.key(seed)
    ks = iter(jax.random.split(key, 48))
    D = D_MODEL

    def nrm(shape, scale):
        return jax.random.normal(next(ks), shape, jnp.float32) * scale

    def gain(shape):
        return 1.0 + nrm(shape, 0.02)

    return {
        "x": nrm((BATCH, SEQ, D), 1.0),
        "mem": nrm((BATCH, MEM_TOKENS, D), 1.0),
        "norm_mix": gain((DEPTH, D)),
        "norm_mem": gain((DEPTH, D)),
        "norm_ffn": gain((DEPTH, D)),
        "norm_final": gain((D,)),
        "mem_norm": gain((D,)),
        "rw_mu": jax.random.uniform(next(ks), (N_RWKV, 6, D), jnp.float32),
        "rw_w_rkv": nrm((N_RWKV, 3, D, D), D ** -0.5),
        "rw_w0": jax.random.uniform(next(ks), (N_RWKV, D), jnp.float32, -6.0, -1.0),
        "rw_w1": nrm((N_RWKV, D, DECAY_LORA), D ** -0.5),
        "rw_w2": nrm((N_RWKV, DECAY_LORA, D), 0.5 * DECAY_LORA ** -0.5),
        "rw_a0": nrm((N_RWKV, D), 0.1),
        "rw_a1": nrm((N_RWKV, D, AAA_LORA), D ** -0.5),
        "rw_a2": nrm((N_RWKV, AAA_LORA, D), 0.5 * AAA_LORA ** -0.5),
        "rw_g1": nrm((N_RWKV, D, GATE_LORA), D ** -0.5),
        "rw_g2": nrm((N_RWKV, GATE_LORA, D), GATE_LORA ** -0.5),
        "rw_k_k": 0.85 + nrm((N_RWKV, D), 0.05),
        "rw_k_a": 1.0 + nrm((N_RWKV, D), 0.05),
        "rw_r_k": nrm((N_RWKV, RWKV_HEADS, RWKV_HEAD_DIM), 0.1),
        "rw_lnx_g": gain((N_RWKV, D)),
        "rw_lnx_b": nrm((N_RWKV, D), 0.02),
        "rw_w_o": nrm((N_RWKV, D, D), D ** -0.5),
        "gm_w_in": nrm((N_SGU, D, 2 * SGU_WIDTH), D ** -0.5),
        "gm_ln_g": gain((N_SGU, SGU_WIDTH)),
        "gm_ln_b": nrm((N_SGU, SGU_WIDTH), 0.02),
        "gm_w_s": nrm((N_SGU, SGU_GROUPS, CHUNK, CHUNK), CHUNK ** -0.5),
        "gm_b_s": 1.0 + nrm((N_SGU, SGU_GROUPS, CHUNK), 0.1),
        "gm_w_out": nrm((N_SGU, SGU_WIDTH, D), SGU_WIDTH ** -0.5),
        "ca_w_q": nrm((DEPTH, D, D), D ** -0.5),
        "ca_w_kv": nrm((DEPTH, D, 2 * D), D ** -0.5),
        "ca_w_o": nrm((DEPTH, D, D), D ** -0.5),
        "ff_w_up": nrm((DEPTH, D, 2 * FFN_WIDTH), D ** -0.5),
        "ff_conv_w": nrm((DEPTH, CONV_WIDTH, FFN_WIDTH), CONV_WIDTH ** -0.5),
        "ff_conv_b": nrm((DEPTH, FFN_WIDTH), 0.02),
        "ff_w_down": nrm((DEPTH, FFN_WIDTH, D), FFN_WIDTH ** -0.5),
    }


def reference(x, mem, norm_mix, norm_mem, norm_ffn, norm_final, mem_norm,
              rw_mu, rw_w_rkv, rw_w0, rw_w1, rw_w2, rw_a0, rw_a1, rw_a2, rw_g1, rw_g2,
              rw_k_k, rw_k_a, rw_r_k, rw_lnx_g, rw_lnx_b, rw_w_o,
              gm_w_in, gm_ln_g, gm_ln_b, gm_w_s, gm_b_s, gm_w_out,
              ca_w_q, ca_w_kv, ca_w_o, ff_w_up, ff_conv_w, ff_conv_b, ff_w_down):
    mem_n = rmsnorm(mem, mem_norm)
    for i in range(DEPTH):
        h = rmsnorm(x, norm_mix[i])
        j = i // N_MIXERS
        if i % N_MIXERS == 0:
            x = x + rwkv7_time_mix(h, rw_mu[j], rw_w_rkv[j], rw_w0[j], rw_w1[j], rw_w2[j],
                                   rw_a0[j], rw_a1[j], rw_a2[j], rw_g1[j], rw_g2[j],
                                   rw_k_k[j], rw_k_a[j], rw_r_k[j], rw_lnx_g[j], rw_lnx_b[j],
                                   rw_w_o[j])
        else:
            x = x + chunked_sgu_mixer(h, gm_w_in[j], gm_ln_g[j], gm_ln_b[j], gm_w_s[j],
                                      gm_b_s[j], gm_w_out[j])
        x = x + memory_cross_attention(rmsnorm(x, norm_mem[i]), mem_n,
                                       ca_w_q[i], ca_w_kv[i], ca_w_o[i])
        x = x + conv_glu_ffn(rmsnorm(x, norm_ffn[i]), ff_w_up[i], ff_conv_w[i],
                             ff_conv_b[i], ff_w_down[i])
    return rmsnorm(x, norm_final)
```

```cpp
#include <hip/hip_runtime.h>
#include <hip/hip_cooperative_groups.h>
#include <cstdio>
#include <cstdint>
namespace cg = cooperative_groups;

#ifndef REP_MASK
#define REP_MASK 0ull
#endif
#ifndef MK_ONE_LAUNCH
#define MK_ONE_LAUNCH 1
#endif

#define LAS __attribute__((address_space(3)))
typedef unsigned short bf16_t;
typedef short bf16x8 __attribute__((ext_vector_type(8)));
typedef float f32x4 __attribute__((ext_vector_type(4)));
typedef float f32x2 __attribute__((ext_vector_type(2)));
typedef unsigned u32x4 __attribute__((ext_vector_type(4)));
typedef unsigned u32x2 __attribute__((ext_vector_type(2)));

constexpr int T_ = 65536, D_ = 1024, SEQ_ = 8192, NB_ = 8, FF_ = 2816;
constexpr size_t MiB = (size_t)1 << 20;
constexpr size_t Mi = (size_t)1 << 20;
constexpr size_t W_RKV = 0, W_L1 = 3 * Mi, W_L2 = W_L1 + 512 * 1024, W_RWO = W_L2 + 768 * 1024, W_GIN = W_RWO + Mi, W_GOUT = W_GIN + 2 * Mi,
                 W_GS = W_GOUT + Mi, W_CAQ = W_GS + 256 * 1024, W_CAKV = W_CAQ + 2 * Mi, W_CAO = W_CAKV + 4 * Mi, W_UP = W_CAO + 2 * Mi,
                 W_DOWN = W_UP + 2 * (size_t)5632 * 1024, W_END = W_DOWN + 2 * (size_t)2816 * 1024;
static_assert(W_END * 2 <= 66 * MiB, "weights");
constexpr size_t WS_BON = 91 * MiB;
constexpr size_t WS_BAR = 95 * MiB;
constexpr size_t WS_SS = 86 * MiB;
constexpr size_t WS_MEMN = 66 * MiB, WS_KM = 70 * MiB, WS_VT = 78 * MiB, WS_BUF = 96 * MiB, SLOT = 128 * MiB;
constexpr int LDS_BYTES = 147456;
constexpr int EXTRA_OFF = 131072;

__device__ __forceinline__ unsigned cvt_pk_bf16(float lo, float hi) { unsigned r; asm volatile("v_cvt_pk_bf16_f32 %0, %1, %2" : "=v"(r) : "v"(lo), "v"(hi)); return r; }
__device__ __forceinline__ float bf_lo(unsigned u) { return __builtin_bit_cast(float, u << 16); }
__device__ __forceinline__ float bf_hi(unsigned u) { return __builtin_bit_cast(float, u & 0xffff0000u); }
__device__ __forceinline__ float sigmoidf_(float x) { return __builtin_amdgcn_rcpf(1.f + __expf(-x)); }
__device__ __forceinline__ float tanhf_(float x) { return 1.f - 2.f * __builtin_amdgcn_rcpf(1.f + __expf(2.f * x)); }
__device__ __forceinline__ float gelu_tanh(float x) { return x * sigmoidf_(1.5957691216f * (x + 0.044715f * x * x * x)); }
template <int CTRL> __device__ __forceinline__ float dpp_mov(float x) { return __builtin_bit_cast(float, __builtin_amdgcn_update_dpp(0, __builtin_bit_cast(int, x), CTRL, 0xf, 0xf, false)); }
__device__ __forceinline__ float red8(float x) { x += dpp_mov<0xB1>(x); x += dpp_mov<0x4E>(x); x += dpp_mov<0x141>(x); return x; }
__device__ __forceinline__ float red16(float x) { x += dpp_mov<0xB1>(x); x += dpp_mov<0x4E>(x); x += dpp_mov<0x141>(x); x += dpp_mov<0x140>(x); return x; }
__device__ __forceinline__ float wave_sum(float v) {
#pragma unroll
    for (int o = 32; o >= 1; o >>= 1) v += __shfl_xor(v, o, 64);
    return v;
}

__device__ __forceinline__ int lgdim() { int g = gridDim.x; asm volatile("" : "+s"(g)); return g; }
__device__ __forceinline__ int lbid() { int b = blockIdx.x; asm volatile("" : "+s"(b)); return b; }
__device__ __forceinline__ int ltid() { int t = threadIdx.x; asm volatile("" : "+v"(t)); return t; }
#define GD_ lgdim()
#define BI_ lbid()
namespace pg8 {
constexpr int BM = 256, BK = 64, HALF = 128, HTB = HALF * BK * 2, NXCD = 8, WGM = 8;
__device__ __forceinline__ int lds_byte(int r, int c) { const int st = (r >> 4) * 2 + (c >> 5), rr = r & 15, cc = c & 31, ob = rr * 64 + cc * 2; return st * 1024 + (ob ^ (((ob >> 9) & 1) << 5)); }
__device__ __forceinline__ void stage_rc(int b, int& R, int& C) { const int st = b / 1024, sb = b % 1024, swz = sb ^ (((sb >> 9) & 1) << 5); R = (st >> 1) * 16 + swz / 64; C = (st & 1) * 32 + (swz % 64) / 2; }
__device__ __forceinline__ int perm32(int rho) { const int n = rho >> 4, i = rho & 15; return 8 * (i >> 2) + 4 * n + (i & 3); }

struct Unit { int pm, pn, z, r0, rend, first; };
struct Gemm { const bf16_t* A; const bf16_t* Bt; int lda, ldb, K, nM, nN, nZ, zdiv; long zA1, zA2, zB1, zB2; int ksplit; long adelta; int ovl; int koffpn, koff; int pm0; };

struct Sched {
    int nM, nN, per, total, G, c, ovl, pm0;
    __device__ __forceinline__ void init(const Gemm& g, int G_, int c_) { nM = g.nM; nN = g.nN; per = nM * nN; total = per * g.nZ; G = G_; c = c_; ovl = g.ovl; pm0 = g.pm0; }
    __device__ __forceinline__ bool next(int i, Unit& u) const {
        const long L = (long)i * G + c; if (L >= total) return false;
        int w = (int)L; { const int q = total / NXCD, r = total % NXCD, xcd = w % NXCD, off = w / NXCD; w = (xcd < r ? xcd * (q + 1) : r * (q + 1) + (xcd - r) * q) + off; }
        u.z = w / per; w -= u.z * per;
        const int nig = WGM * nN, gid = w / nig, fm = gid * WGM, gsz = (nM - fm) < WGM ? (nM - fm) : WGM;
        u.pm = fm + ((w % nig) % gsz); u.pn = (w % nig) / gsz;
        u.pm += pm0;
        { const int b = u.pm / 33, j = u.pm - b * 33, r0o = b * SEQ_ + 254 * j - 2, eo = (b + 1) * SEQ_, ro = (r0o + BM < eo) ? r0o + BM : eo;
          const int r0 = ovl ? r0o : u.pm * BM, re = ovl ? ro : u.pm * BM + BM, fi = ovl ? (int)(j == 0) : 0; u.r0 = r0; u.rend = re; u.first = fi; }
        return true;
    }
};
__device__ __forceinline__ const char* unitA(const Gemm& g, const Unit& u) { return (const char*)(g.A + (long)(u.z / g.zdiv) * g.zA1 + (long)(u.z % g.zdiv) * g.zA2 + (long)u.r0 * g.lda + (u.pn >= g.koffpn ? g.koff : 0)); }
__device__ __forceinline__ const char* unitB(const Gemm& g, const Unit& u) { return (const char*)(g.Bt + (long)(u.z / g.zdiv) * g.zB1 + (long)(u.z % g.zdiv) * g.zB2 + (long)u.pn * BM * g.ldb + (u.pn >= g.koffpn ? g.koff : 0)); }

enum { OP_NONE = 0, OP_LORA1 = 2, OP_LORA2 = 3, OP_GELU = 4 };
struct EpiBfData { bf16_t* O; int ldc; int zdiv; long zO1, zO2; int split_cols; long split_stride; const float* p0; const float* p1; float scale; const float* ss; float* vs; LAS float* red; };
template <int OP> struct EpiBf : EpiBfData {
    static constexpr bool PERM = true, HAS_PF = false;
    __device__ __forceinline__ void operator()(const f32x4 (&acc)[2][2][4][2], const Unit& u, int wr, int wc, int fr, int fq) const {
        const int row0 = u.r0 + wr * 64 + fr; int colt = u.pn * BM; bf16_t* base = O + (long)(u.z / zdiv) * zO1 + (long)(u.z % zdiv) * zO2;
        if (split_cols) { const int t = colt / split_cols; base += (long)t * split_stride; colt -= t * split_cols; }
        const int col0 = colt + wc * 64 + 8 * fq, gcol0 = u.pn * BM + wc * 64 + 8 * fq;
        float rsv[8];
#pragma unroll
        for (int i = 0; i < 8; ++i) rsv[i] = 1024.f;
        if (OP == OP_NONE || OP == OP_GELU) { if (ss) {
#pragma unroll
            for (int i = 0; i < 8; ++i) { const f32x4 t = *(const f32x4*)(ss + (long)(row0 + (i >> 2) * HALF + (i & 3) * 16) * 4); rsv[i] = (t[0] + t[1]) + (t[2] + t[3]); } } }
#pragma unroll
        for (int ai = 0; ai < 2; ++ai)
#pragma unroll
            for (int m = 0; m < 4; ++m) {
                const int row = row0 + ai * HALF + m * 16;
                float rs = scale, t1 = 0.f, t2 = 0.f;
                if (OP == OP_NONE || OP == OP_GELU) { if (ss) rs *= rsqrtf(rsv[ai * 4 + m] * (1.f / 1024.f) + 1e-6f); }
#pragma unroll
                for (int bj = 0; bj < 2; ++bj) {
                    const int gc = gcol0 + bj * 32;
                    f32x4 q0 = {0.f, 0.f, 0.f, 0.f}, q1 = {0.f, 0.f, 0.f, 0.f};
                    if (OP == OP_LORA2) { if (gc < 1024) { q0 = *(const f32x4*)(p0 + gc); q1 = *(const f32x4*)(p0 + gc + 4); } else if (gc < 2048) { q0 = *(const f32x4*)(p1 + gc - 1024); q1 = *(const f32x4*)(p1 + gc - 1024 + 4); } }
                    bf16_t* rowp = base + (long)row * ldc + col0 + bj * 32;
                    f32x4 v0 = acc[ai][bj][m][0], v1 = acc[ai][bj][m][1];
                    if (OP == OP_NONE || OP == OP_GELU) { v0 = v0 * rs; v1 = v1 * rs; }
                    if (OP == OP_LORA1) {
                        if (gc < 64) { for (int e = 0; e < 4; ++e) { v0[e] = tanhf_(v0[e]); v1[e] = tanhf_(v1[e]); } }
                        else if (gc >= 128) { for (int e = 0; e < 4; ++e) { v0[e] = sigmoidf_(v0[e]); v1[e] = sigmoidf_(v1[e]); } }
                    }
                    if (OP == OP_LORA2) {
                        if (gc < 1024) { for (int e = 0; e < 4; ++e) { v0[e] = 0.6065306597f * sigmoidf_(v0[e] + q0[e]); v1[e] = 0.6065306597f * sigmoidf_(v1[e] + q1[e]); } }
                        else if (gc < 2048) { for (int e = 0; e < 4; ++e) { v0[e] = sigmoidf_(v0[e] + q0[e]); v1[e] = sigmoidf_(v1[e] + q1[e]); } }
                    }
                    if (OP == OP_GELU) { for (int e = 0; e < 4; ++e) { v0[e] = gelu_tanh(v0[e]); v1[e] = gelu_tanh(v1[e]); t1 += v0[e] + v1[e]; t2 += v0[e] * v0[e] + v1[e] * v1[e]; } }
                    u32x4 w; w.x = cvt_pk_bf16(v0[0], v0[1]); w.y = cvt_pk_bf16(v0[2], v0[3]); w.z = cvt_pk_bf16(v1[0], v1[1]); w.w = cvt_pk_bf16(v1[2], v1[3]);
                    *(u32x4*)rowp = w;
                }
                if (OP == OP_GELU) { if (vs && u.pn >= 4) { t1 += __shfl_xor(t1, 16, 64); t1 += __shfl_xor(t1, 32, 64); t2 += __shfl_xor(t2, 16, 64); t2 += __shfl_xor(t2, 32, 64);
                    if (fq == 0) { LAS float* d = red + ((ai * HALF + wr * 64 + m * 16 + fr) * 4 + wc) * 2; d[0] = t1; d[1] = t2; } } }
            }
        if (OP == OP_GELU) { if (vs && u.pn >= 4) {
            asm volatile("s_waitcnt lgkmcnt(0)" ::: "memory"); __builtin_amdgcn_s_barrier(); asm volatile("" ::: "memory");
            if (wc == 0 && fq == 0) {
#pragma unroll
                for (int ai = 0; ai < 2; ++ai)
#pragma unroll
                    for (int m = 0; m < 4; ++m) { const int rl = ai * HALF + wr * 64 + m * 16 + fr; const f32x4 a = *(const LAS f32x4*)(red + rl * 8), b = *(const LAS f32x4*)(red + rl * 8 + 4);
                        *(f32x2*)(vs + (long)(u.r0 + rl) * 8 + (u.pn - 4) * 2) = (f32x2){(a[0] + a[2]) + (b[0] + b[2]), (a[1] + a[3]) + (b[1] + b[3])}; }
            } } }
    }
};
struct EpiRes {
    static constexpr bool PERM = true, HAS_PF = false;
    const float* res32; bf16_t* xb; float* ss; int ldc; LAS float* red;
    __device__ __forceinline__ void operator()(const f32x4 (&acc)[2][2][4][2], const Unit& u, int wr, int wc, int fr, int fq) const {
        const int row0 = u.r0 + wr * 64 + fr, col0 = u.pn * BM + wc * 64 + 8 * fq;
#pragma unroll
        for (int ai = 0; ai < 2; ++ai)
#pragma unroll
            for (int m = 0; m < 4; ++m) {
                const int row = row0 + ai * HALF + m * 16;
                const long ro = (long)row * ldc + col0; float sq = 0.f;
#pragma unroll
                for (int bj = 0; bj < 2; ++bj) {
                    f32x4 r0, r1;
                    if (res32) { r0 = *(const f32x4*)(res32 + ro + bj * 32); r1 = *(const f32x4*)(res32 + ro + bj * 32 + 4); }
                    else { const u32x4 t = *(const u32x4*)(xb + ro + bj * 32); r0 = (f32x4){bf_lo(t.x), bf_hi(t.x), bf_lo(t.y), bf_hi(t.y)}; r1 = (f32x4){bf_lo(t.z), bf_hi(t.z), bf_lo(t.w), bf_hi(t.w)}; }
                    r0 = r0 + acc[ai][bj][m][0]; r1 = r1 + acc[ai][bj][m][1];
                    u32x4 w; w.x = cvt_pk_bf16(r0[0], r0[1]); w.y = cvt_pk_bf16(r0[2], r0[3]); w.z = cvt_pk_bf16(r1[0], r1[1]); w.w = cvt_pk_bf16(r1[2], r1[3]);
                    *(u32x4*)(xb + ro + bj * 32) = w;
                    sq += r0[0] * r0[0] + r0[1] * r0[1] + r0[2] * r0[2] + r0[3] * r0[3] + r1[0] * r1[0] + r1[1] * r1[1] + r1[2] * r1[2] + r1[3] * r1[3];
                }
                if (ss) { sq += __shfl_xor(sq, 16, 64); sq += __shfl_xor(sq, 32, 64); if (fq == 0) red[(ai * HALF + wr * 64 + m * 16 + fr) * 4 + wc] = sq; }
            }
        if (ss) {
            asm volatile("s_waitcnt lgkmcnt(0)" ::: "memory"); __builtin_amdgcn_s_barrier(); asm volatile("" ::: "memory");
            if (wc == 0 && fq == 0) {
#pragma unroll
                for (int ai = 0; ai < 2; ++ai)
#pragma unroll
                    for (int m = 0; m < 4; ++m) { const int rl = ai * HALF + wr * 64 + m * 16 + fr; const f32x4 r4 = *(const LAS f32x4*)(red + rl * 4);
                        ss[(long)(u.r0 + rl) * 4 + u.pn] = (r4[0] + r4[1]) + (r4[2] + r4[3]); }
            }
        }
    }
};
struct EpiConv {
    static constexpr bool PERM = true, HAS_PF = true;
    __device__ __forceinline__ void prefetch(const Unit& u, LAS unsigned char* lds, int wid, int lane) const {
        if (wid < 4) __builtin_amdgcn_global_load_lds((const unsigned*)(ss + (long)(u.r0 + wid * 64 + lane) * 4), (LAS unsigned*)(lds + EXTRA_OFF + 8192 + wid * 1024), 16, 0, 0);
        else if (wid < 6) { const int t = (wid - 4) * 64 + lane, arr = t >> 5, part = t & 31;
            const float* src = (arr < 3 ? cw + arr * FF_ : cb) + u.pn * HALF + part * 4;
            __builtin_amdgcn_global_load_lds((const unsigned*)src, (LAS unsigned*)(lds + EXTRA_OFF + 12288 + (wid - 4) * 1024), 16, 0, 0); }
    }
    bf16_t* H; const float* cw; const float* cb; const float* ss; LAS float* ex;
    __device__ __forceinline__ void operator()(f32x4 (&acc)[2][2][4][2], const Unit& u, int wr, int wc, int fr, int fq) const {
        const int rowb = u.r0 + wr * 64 + fr, colg = u.pn * HALF + wc * 32 + 8 * fq;
#pragma unroll
        for (int ai = 0; ai < 2; ++ai)
#pragma unroll
            for (int m = 0; m < 4; ++m) {
                const f32x4 st4 = *(const LAS f32x4*)(ex + 2048 + (wr * 64 + fr + ai * HALF + m * 16) * 4);   float rs = rsqrtf(((st4[0] + st4[1]) + (st4[2] + st4[3])) * (1.f / 1024.f) + 1e-6f);
                const bool zg = (u.first && ai == 0 && m == 0 && wr == 0 && fr < 2);
                acc[ai][1][m][0] = acc[ai][1][m][0] * rs; acc[ai][1][m][1] = acc[ai][1][m][1] * rs;
                if (zg) { acc[ai][0][m][0] = (f32x4){0.f, 0.f, 0.f, 0.f}; acc[ai][0][m][1] = (f32x4){0.f, 0.f, 0.f, 0.f}; }
                else { acc[ai][0][m][0] = acc[ai][0][m][0] * rs; acc[ai][0][m][1] = acc[ai][0][m][1] * rs; }
            }
        if (fr >= 14) {
#pragma unroll
            for (int ai = 0; ai < 2; ++ai) { LAS float* d = ex + ((((ai * 2 + wr) * 4 + wc) * 2 + (fr - 14)) * 32 + fq * 8); *(LAS f32x4*)d = acc[ai][0][3][0]; *(LAS f32x4*)(d + 4) = acc[ai][0][3][1]; }
        }
        f32x4 w0[2], w1[2], w2[2], bb[2];
#pragma unroll
        for (int n = 0; n < 2; ++n) { const LAS float* cl = ex + 3072 + wc * 32 + 8 * fq + 4 * n; w0[n] = *(const LAS f32x4*)cl; w1[n] = *(const LAS f32x4*)(cl + 128); w2[n] = *(const LAS f32x4*)(cl + 256); bb[n] = *(const LAS f32x4*)(cl + 384); }
        asm volatile("s_waitcnt lgkmcnt(0)" ::: "memory"); __builtin_amdgcn_s_barrier(); asm volatile("" ::: "memory");
#pragma unroll
        for (int ai = 0; ai < 2; ++ai)
#pragma unroll
            for (int m = 0; m < 4; ++m) {
                const int row = rowb + ai * HALF + m * 16;
                u32x4 w;
                f32x4 P1[2] = {{0.f, 0.f, 0.f, 0.f}, {0.f, 0.f, 0.f, 0.f}}, P2[2] = {{0.f, 0.f, 0.f, 0.f}, {0.f, 0.f, 0.f, 0.f}};
                if (m == 0) { const int pblk = ai * 2 + wr - 1;
                    if (pblk >= 0) { const LAS float* s = ex + ((pblk * 4 + wc) * 2) * 32 + fq * 8; P2[0] = *(const LAS f32x4*)s; P2[1] = *(const LAS f32x4*)(s + 4); P1[0] = *(const LAS f32x4*)(s + 32); P1[1] = *(const LAS f32x4*)(s + 36); } }
#pragma unroll
                for (int n = 0; n < 2; ++n) {
                    float hh[4];
#pragma unroll
                    for (int i = 0; i < 4; ++i) {
                        const float g0 = acc[ai][0][m][n][i];
                        float o1, o2;
                        if (m > 0) { const float pv = acc[ai][0][m > 0 ? m - 1 : 0][n][i]; o1 = dpp_mov<0x121>(pv); o2 = dpp_mov<0x122>(pv); }
                        else { o1 = P1[n][i]; o2 = (fr == 0) ? P2[n][i] : P1[n][i]; }
                        const float up1 = __builtin_bit_cast(float, __builtin_amdgcn_update_dpp(__builtin_bit_cast(int, o1), __builtin_bit_cast(int, g0), 0x111, 0xf, 0xf, false));
                        const float up2 = __builtin_bit_cast(float, __builtin_amdgcn_update_dpp(__builtin_bit_cast(int, o2), __builtin_bit_cast(int, g0), 0x112, 0xf, 0xf, false));
                        const float cv = up2 * w0[n][i] + up1 * w1[n][i] + g0 * w2[n][i] + bb[n][i];
                        hh[i] = cv * sigmoidf_(cv) * acc[ai][1][m][n][i];
                    }
                    if (n == 0) { w.x = cvt_pk_bf16(hh[0], hh[1]); w.y = cvt_pk_bf16(hh[2], hh[3]); } else { w.z = cvt_pk_bf16(hh[0], hh[1]); w.w = cvt_pk_bf16(hh[2], hh[3]); }
                }
                if (row >= u.r0 + 2 && row < u.rend) *(u32x4*)(H + (long)row * FF_ + colg) = w;
            }
    }
};
struct EpiSoftmax {
    static constexpr bool PERM = true, HAS_PF = false;
    bf16_t* P; LAS float* red;
    __device__ __forceinline__ void operator()(f32x4 (&acc)[2][2][4][2], const Unit& u, int wr, int wc, int fr, int fq) const {
        float mx[2][4];
#pragma unroll
        for (int ai = 0; ai < 2; ++ai)
#pragma unroll
            for (int m = 0; m < 4; ++m) {
                float v = -3.0e38f;
#pragma unroll
                for (int bj = 0; bj < 2; ++bj)
#pragma unroll
                    for (int n = 0; n < 2; ++n)
#pragma unroll
                        for (int e = 0; e < 4; ++e) v = fmaxf(v, acc[ai][bj][m][n][e]);
                v = fmaxf(v, __shfl_xor(v, 16, 64)); v = fmaxf(v, __shfl_xor(v, 32, 64));
                if (fq == 0) red[(ai * HALF + wr * 64 + m * 16 + fr) * 4 + wc] = v;
                mx[ai][m] = v;
            }
        asm volatile("s_waitcnt lgkmcnt(0)" ::: "memory"); __builtin_amdgcn_s_barrier(); asm volatile("" ::: "memory");
#pragma unroll
        for (int ai = 0; ai < 2; ++ai)
#pragma unroll
            for (int m = 0; m < 4; ++m) {
                const f32x4 r4 = *(const LAS f32x4*)(red + (ai * HALF + wr * 64 + m * 16 + fr) * 4);
                const float M = fmaxf(fmaxf(r4[0], r4[1]), fmaxf(r4[2], r4[3]));
                float s = 0.f;
#pragma unroll
                for (int bj = 0; bj < 2; ++bj)
#pragma unroll
                    for (int n = 0; n < 2; ++n)
#pragma unroll
                        for (int e = 0; e < 4; ++e) { const float p = __expf(acc[ai][bj][m][n][e] - M); acc[ai][bj][m][n][e] = p; s += p; }
                s += __shfl_xor(s, 16, 64); s += __shfl_xor(s, 32, 64);
                if (fq == 0) red[1024 + (ai * HALF + wr * 64 + m * 16 + fr) * 4 + wc] = s;
            }
        asm volatile("s_waitcnt lgkmcnt(0)" ::: "memory"); __builtin_amdgcn_s_barrier(); asm volatile("" ::: "memory");
        const int b = u.z >> 2, h = u.z & 3;
        bf16_t* base = P + ((long)b * SEQ_ + u.r0 + wr * 64 + fr) * D_ + h * 256 + wc * 64 + 8 * fq;
#pragma unroll
        for (int ai = 0; ai < 2; ++ai)
#pragma unroll
            for (int m = 0; m < 4; ++m) {
                const f32x4 r4 = *(const LAS f32x4*)(red + 1024 + (ai * HALF + wr * 64 + m * 16 + fr) * 4);
                const float inv = 1.f / (r4[0] + r4[1] + r4[2] + r4[3]);
#pragma unroll
                for (int bj = 0; bj < 2; ++bj) {
                    const f32x4 v0 = acc[ai][bj][m][0] * inv, v1 = acc[ai][bj][m][1] * inv;
                    u32x4 w; w.x = cvt_pk_bf16(v0[0], v0[1]); w.y = cvt_pk_bf16(v0[2], v0[3]); w.z = cvt_pk_bf16(v1[0], v1[1]); w.w = cvt_pk_bf16(v1[2], v1[3]);
                    *(u32x4*)(base + (long)(ai * HALF + m * 16) * D_ + bj * 32) = w;
                }
            }
    }
};

template <class Epi> struct MakeEpi;
template <class Epi, bool SPLITA, class PT>
__device__ __forceinline__ void gemm_phase(LAS unsigned char* lds, const Gemm g, const PT& P, int step, int Gs = 0, int bi = 0) {
    const int tid = ltid(), wid = __builtin_amdgcn_readfirstlane(tid >> 6), lane = tid & 63, wr = wid >> 2, wc = wid & 3, fr = lane & 15, fq = lane >> 4;
    const int K = g.K, nt = K / BK;
    Sched S; if (Gs > 0) S.init(g, Gs, bi); else S.init(g, GD_, BI_);
    unsigned voffA[2], voffB[2];
#pragma unroll
    for (int i = 0; i < 2; ++i) { int R, C; stage_rc(tid * 16 + i * 8192, R, C); const int Rb = Epi::PERM ? (64 * (R >> 5) + perm32(R & 31)) : R;
        voffA[i] = (unsigned)(R * g.lda + C) * 2u; voffB[i] = (unsigned)(Rb * g.ldb + C) * 2u; }
    const size_t kstep = (size_t)(BK * 2);
    const size_t hstepA = (size_t)HALF * g.lda * 2, hstepB = (size_t)(Epi::PERM ? 32 : HALF) * g.ldb * 2;
    const unsigned ldsw = (unsigned)wid * 1024u;
    const int aoff = lds_byte(wr * 64 + fr, fq * 8), boff = lds_byte(wc * 32 + fr, fq * 8);
#define PG8_SA(b, h) (((b) * 2 + (h)) * HTB)
#define PG8_SB(b, h) ((4 + (b) * 2 + (h)) * HTB)
#define PG8_STAGE(bufoff, gbase, voff) do { _Pragma("unroll") for (int _i = 0; _i < 2; ++_i) \
        __builtin_amdgcn_global_load_lds((const unsigned*)((const char*)(gbase) + (voff)[_i]), (LAS unsigned*)(lds + (bufoff) + ldsw + _i * 8192), 16, 0, 0); } while (0)
#define PG8_LDA(dst, b, h) do { _Pragma("unroll") for (int m = 0; m < 4; ++m) _Pragma("unroll") for (int k = 0; k < 2; ++k) dst[m][k] = *(const LAS bf16x8*)(lds + PG8_SA(b, h) + aoff + m * 2048 + k * 1024); } while (0)
#define PG8_LDB(dst, b, h) do { _Pragma("unroll") for (int n = 0; n < 2; ++n) _Pragma("unroll") for (int k = 0; k < 2; ++k) dst[n][k] = *(const LAS bf16x8*)(lds + PG8_SB(b, h) + boff + n * 2048 + k * 1024); } while (0)
#define PG8_MMA(ai, bj, At, Bt) do { __builtin_amdgcn_s_setprio(1); _Pragma("unroll") for (int m = 0; m < 4; ++m) _Pragma("unroll") for (int n = 0; n < 2; ++n) _Pragma("unroll") for (int k = 0; k < 2; ++k) \
        acc[ai][bj][m][n] = __builtin_amdgcn_mfma_f32_16x16x32_bf16(Bt[n][k], At[m][k], acc[ai][bj][m][n], 0, 0, 0); __builtin_amdgcn_s_setprio(0); } while (0)
#define PG8_WAIT_V(n) asm volatile("s_waitcnt vmcnt(" #n ")" ::: "memory")
#define PG8_WAIT_L(n) asm volatile("s_waitcnt lgkmcnt(" #n ")" ::: "memory")
#define PG8_BAR __builtin_amdgcn_s_barrier()
#define PG8_SCHED __builtin_amdgcn_sched_barrier(0)
#define PG8_AK(base, t) ((base) + (size_t)(t) * kstep + ((SPLITA && (t) >= g.ksplit) ? g.adelta : 0l))
    Unit cur, nxt; int ui = 0;
    if (!S.next(0, cur)) return;
    f32x4 acc[2][2][4][2];
#pragma unroll
    for (int a = 0; a < 2; ++a)
#pragma unroll
        for (int b = 0; b < 2; ++b)
#pragma unroll
            for (int m = 0; m < 4; ++m)
#pragma unroll
                for (int n = 0; n < 2; ++n) acc[a][b][m][n] = (f32x4){0.f, 0.f, 0.f, 0.f};
    bf16x8 At[4][2], B0[2][2], B1[2][2];
    const char* cA = unitA(g, cur); const char* cB = unitB(g, cur);
    PG8_STAGE(PG8_SB(0, 0), cB, voffB); PG8_STAGE(PG8_SB(0, 1), cB + hstepB, voffB); PG8_STAGE(PG8_SA(0, 0), cA, voffA); PG8_STAGE(PG8_SA(0, 1), cA + hstepA, voffA);
    if (wr == 1) PG8_BAR;
    PG8_WAIT_V(2); PG8_BAR;
    PG8_STAGE(PG8_SB(1, 0), cB + kstep, voffB); PG8_STAGE(PG8_SA(1, 0), cA + kstep, voffA); PG8_STAGE(PG8_SB(1, 1), cB + hstepB + kstep, voffB);
    PG8_WAIT_V(6); PG8_BAR;
    for (;;) {
        const bool has_next = S.next(ui + 1, nxt);
        const char* nA = has_next ? unitA(g, nxt) : cA; const char* nB = has_next ? unitB(g, nxt) : cB;
        if constexpr (Epi::HAS_PF) { int st3 = step; asm volatile("" : "+s"(st3)); const Epi Ep = MakeEpi<Epi>::make(P, st3, lds); Ep.prefetch(cur, lds, wid, lane); }
        for (int t = 0; t < nt; t += 2) {
            const bool last = (t == nt - 2);
            const char* a1 = PG8_AK(cA, t + 1);
            const char* a2 = last ? nA : PG8_AK(cA, t + 2); const char* b2 = last ? nB : cB + (size_t)(t + 2) * kstep;
            const char* a3 = last ? nA + kstep : PG8_AK(cA, t + 3); const char* b3 = b2 + kstep;
            PG8_LDB(B0, 0, 0); PG8_LDB(B1, 0, 1); PG8_SCHED; PG8_LDA(At, 0, 0); PG8_STAGE(PG8_SA(1, 1), a1 + hstepA, voffA);
            PG8_WAIT_V(8); PG8_WAIT_L(0); PG8_BAR; PG8_MMA(0, 0, At, B0); PG8_MMA(0, 1, At, B1); PG8_BAR; PG8_SCHED;
            PG8_LDA(At, 0, 1); PG8_STAGE(PG8_SB(0, 0), b2, voffB); PG8_STAGE(PG8_SB(0, 1), b2 + hstepB, voffB); PG8_STAGE(PG8_SA(0, 0), a2, voffA);
            PG8_WAIT_V(8); PG8_WAIT_L(0); PG8_BAR; PG8_MMA(1, 0, At, B0); PG8_MMA(1, 1, At, B1); PG8_BAR; PG8_SCHED;
            PG8_LDB(B0, 1, 0); PG8_LDB(B1, 1, 1); PG8_SCHED; PG8_LDA(At, 1, 0); PG8_STAGE(PG8_SA(0, 1), a2 + hstepA, voffA);
            PG8_WAIT_V(8); PG8_WAIT_L(0); PG8_BAR; PG8_MMA(0, 0, At, B0); PG8_MMA(0, 1, At, B1); PG8_BAR; PG8_SCHED;
            PG8_LDA(At, 1, 1); PG8_STAGE(PG8_SB(1, 0), b3, voffB); PG8_STAGE(PG8_SB(1, 1), b3 + hstepB, voffB); PG8_STAGE(PG8_SA(1, 0), a3, voffA);
            PG8_WAIT_V(8); PG8_WAIT_L(0); PG8_BAR; PG8_MMA(1, 0, At, B0); PG8_MMA(1, 1, At, B1); PG8_BAR; PG8_SCHED;
        }
        if (wr == 0) PG8_BAR;
        { int st2 = step; asm volatile("" : "+s"(st2)); const Epi E = MakeEpi<Epi>::make(P, st2, lds); E(acc, cur, wr, wc, fr, fq); }
        if (!has_next) break;
#pragma unroll
        for (int a = 0; a < 2; ++a)
#pragma unroll
            for (int b = 0; b < 2; ++b)
#pragma unroll
                for (int m = 0; m < 4; ++m)
#pragma unroll
                    for (int n = 0; n < 2; ++n) acc[a][b][m][n] = (f32x4){0.f, 0.f, 0.f, 0.f};
        cur = nxt; cA = nA; cB = nB; ++ui;
        if (wr == 1) PG8_BAR;
    }
    PG8_WAIT_V(0);
    PG8_BAR;
#undef PG8_SA
#undef PG8_SB
#undef PG8_STAGE
#undef PG8_LDA
#undef PG8_LDB
#undef PG8_MMA
#undef PG8_WAIT_V
#undef PG8_WAIT_L
#undef PG8_BAR
#undef PG8_SCHED
#undef PG8_AK
}
}

struct Params { const float* in[36]; float* out; unsigned char* ws; int ph_lo, ph_hi; };
enum { I_X = 0, I_MEM, I_NMIX, I_NMEM, I_NFFN, I_NFIN, I_MEMNORM, I_MU, I_WRKV, I_W0, I_W1, I_W2, I_A0, I_A1, I_A2, I_G1, I_G2, I_KK, I_KA, I_RK, I_LNXG, I_LNXB, I_RWO,
       I_GIN, I_GLNG, I_GLNB, I_GWS, I_GBS, I_GOUT, I_CAQ, I_CAKV, I_CAO, I_UP, I_CONVW, I_CONVB, I_DOWN };

__device__ __forceinline__ bf16_t* wsW(const Params& p, size_t eoff) { return (bf16_t*)p.ws + eoff; }
__device__ __forceinline__ bf16_t* slot(const Params& p, int i) { return (bf16_t*)(p.ws + WS_BUF + (size_t)i * SLOT); }

__device__ __forceinline__ void tr_job(const float* src, int K, int N, bf16_t* dst, int ldt, int& gbase, LAS float* tile, const float* rowscale = nullptr, int upmap = 0, int bi = -1, int Gs = 0) {
    const int tid = ltid(), ntn = N / 64, nt = (K / 64) * ntn, G = (bi >= 0) ? Gs : GD_; if (bi < 0) bi = BI_;
    int g = gbase + ((bi - gbase) % G + G) % G;
    for (; g < gbase + nt; g += G) {
        const int ti = g - gbase, k0 = (ti / ntn) * 64, n0 = (ti % ntn) * 64;
        __syncthreads();
        { const int kk = tid >> 4, n4 = (tid & 15) * 4;
#pragma unroll
          for (int h = 0; h < 2; ++h) { f32x4 v = *(const f32x4*)(src + (size_t)(k0 + kk + h * 32) * N + n0 + n4); if (rowscale) v = v * rowscale[k0 + kk + h * 32];
              LAS float* d = tile + (kk + h * 32) * 65 + n4; d[0] = v[0]; d[1] = v[1]; d[2] = v[2]; d[3] = v[3]; } }
        __syncthreads();
        { const int nn = tid >> 3, k8 = (tid & 7) * 8; float v[8];
#pragma unroll
          for (int j = 0; j < 8; ++j) v[j] = tile[(k8 + j) * 65 + nn];
          u32x4 w; w.x = cvt_pk_bf16(v[0], v[1]); w.y = cvt_pk_bf16(v[2], v[3]); w.z = cvt_pk_bf16(v[4], v[5]); w.w = cvt_pk_bf16(v[6], v[7]);
          int dr = n0 + nn; if (upmap) { const int nv = (n0 < FF_) ? n0 : n0 - FF_; dr = 256 * (nv / 128) + 2 * (nv % 128) + ((n0 < FF_) ? 0 : 32) + nn + ((nn >= 32) ? 32 : 0); }
          *(u32x4*)(dst + (size_t)dr * ldt + k0 + k8) = w; }
    }
    gbase += nt;
}
__device__ __forceinline__ unsigned short bf1(float v) { return (unsigned short)(cvt_pk_bf16(v, 0.f) & 0xffffu); }

__device__ __forceinline__ void phase_convert_late(const Params& p, LAS unsigned char* lds, int bi, int Gs) {
    LAS float* tile = (LAS float*)lds;
    int gb = 0;
    tr_job(p.in[I_GIN], 1024, 2048, wsW(p, W_GIN), 1024, gb, tile, p.in[I_NMIX] + 1024, 0, bi, Gs);
    tr_job(p.in[I_GOUT], 1024, 1024, wsW(p, W_GOUT), 1024, gb, tile, nullptr, 0, bi, Gs);
    for (int l = 0; l < 2; ++l) {
        tr_job(p.in[I_CAQ] + (size_t)l * Mi, 1024, 1024, wsW(p, W_CAQ + l * Mi), 1024, gb, tile, p.in[I_NMEM] + l * 1024, 0, bi, Gs);
        tr_job(p.in[I_CAO] + (size_t)l * Mi, 1024, 1024, wsW(p, W_CAO + l * Mi), 1024, gb, tile, nullptr, 0, bi, Gs);
        tr_job(p.in[I_UP] + (size_t)l * 5632 * 1024, 1024, 5632, wsW(p, W_UP + (size_t)l * 5632 * 1024), 1024, gb, tile, p.in[I_NFFN] + l * 1024, 1, bi, Gs);
        tr_job(p.in[I_DOWN] + (size_t)l * 2816 * 1024, 2816, 1024, wsW(p, W_DOWN + (size_t)l * 2816 * 1024), 2816, gb, tile, nullptr, 0, bi, Gs);
    }
    const int tid0 = ltid();
    for (int idx = bi * 512 + tid0; idx < 16 * 128 * 128; idx += Gs * 512) {
        const int t = (idx >> 7) & 127, s = idx & 127;
        wsW(p, W_GS)[idx] = bf1(s <= t ? p.in[I_GWS][idx] : 0.f);
    }
}
__device__ __forceinline__ void phase_prologue(const Params& p, LAS unsigned char* lds) {
    LAS float* tile = (LAS float*)lds;
    int gb = 0;
    for (int j = 0; j < 3; ++j) tr_job(p.in[I_WRKV] + (size_t)j * Mi, 1024, 1024, wsW(p, W_RKV + j * Mi), 1024, gb, tile);
    tr_job(p.in[I_RWO], 1024, 1024, wsW(p, W_RWO), 1024, gb, tile);
    for (int l = 0; l < 2; ++l) tr_job(p.in[I_CAKV] + (size_t)l * 2 * Mi, 1024, 2048, wsW(p, W_CAKV + l * 2 * Mi), 1024, gb, tile);
    const int tid0 = ltid(); const int gtid = BI_ * 512 + tid0, gth = GD_ * 512;
    for (int idx = gtid; idx < 256 * 2048; idx += gth) {
        const int n = idx >> 11, k = idx & 2047, kk = k & 1023;
        const float* src; int nn, Ns, mi;
        if (n < 64) { src = p.in[I_W1]; nn = n; Ns = 64; mi = 1; } else if (n < 128) { src = p.in[I_A1]; nn = n - 64; Ns = 64; mi = 4; } else { src = p.in[I_G1]; nn = n - 128; Ns = 128; mi = 5; }
        float v = src[kk * Ns + nn]; if (k >= 1024) v *= (p.in[I_MU][mi * 1024 + kk] - p.in[I_MU][kk]);
        wsW(p, W_L1)[idx] = bf1(v);
    }
    for (int idx = gtid; idx < 3072 * 256; idx += gth) {
        const int n = idx >> 8, k = idx & 255; float v = 0.f;
        if (n < 1024) { if (k < 64) v = p.in[I_W2][k * 1024 + n]; }
        else if (n < 2048) { if (k >= 64 && k < 128) v = p.in[I_A2][(k - 64) * 1024 + n - 1024]; }
        else { if (k >= 128) v = p.in[I_G2][(k - 128) * 1024 + n - 2048]; }
        wsW(p, W_L2)[idx] = bf1(v);
    }
    const int wave = tid0 >> 6, lane = tid0 & 63;
    for (int row = BI_ * 8 + wave; row < 2048; row += GD_ * 8) {
        const float* xr = p.in[I_MEM] + (size_t)row * 1024; f32x4 v[4]; float ss = 0.f;
#pragma unroll
        for (int i = 0; i < 4; ++i) { v[i] = *(const f32x4*)(xr + i * 256 + lane * 4); ss += v[i][0] * v[i][0] + v[i][1] * v[i][1] + v[i][2] * v[i][2] + v[i][3] * v[i][3]; }
        ss = wave_sum(ss); const float rs = rsqrtf(ss * (1.f / 1024.f) + 1e-6f);
        bf16_t* o = (bf16_t*)(p.ws + WS_MEMN) + (size_t)row * 1024;
#pragma unroll
        for (int i = 0; i < 4; ++i) { const f32x4 g = *(const f32x4*)(p.in[I_MEMNORM] + i * 256 + lane * 4);
            u32x2 w; w.x = cvt_pk_bf16(v[i][0] * rs * g[0], v[i][1] * rs * g[1]); w.y = cvt_pk_bf16(v[i][2] * rs * g[2], v[i][3] * rs * g[3]);
            *(u32x2*)(o + i * 256 + lane * 4) = w; }
    }
}

__device__ __forceinline__ void phase_rms(const float* x, const float* gain, bf16_t* out) {
    const int tid0 = ltid(); const int wave = tid0 >> 6, lane = tid0 & 63;
    f32x4 g[4];
#pragma unroll
    for (int i = 0; i < 4; ++i) g[i] = *(const f32x4*)(gain + i * 256 + lane * 4);
    for (int row = BI_ * 8 + wave; row < T_; row += GD_ * 8) {
        const float* xr = x + (size_t)row * 1024; f32x4 v[4]; float ss = 0.f;
#pragma unroll
        for (int i = 0; i < 4; ++i) { v[i] = *(const f32x4*)(xr + i * 256 + lane * 4); ss += v[i][0] * v[i][0] + v[i][1] * v[i][1] + v[i][2] * v[i][2] + v[i][3] * v[i][3]; }
        ss = wave_sum(ss); const float rs = rsqrtf(ss * (1.f / 1024.f) + 1e-6f);
        bf16_t* o = out + (size_t)row * 1024;
#pragma unroll
        for (int i = 0; i < 4; ++i) { u32x2 w; w.x = cvt_pk_bf16(v[i][0] * rs * g[i][0], v[i][1] * rs * g[i][1]); w.y = cvt_pk_bf16(v[i][2] * rs * g[i][2], v[i][3] * rs * g[i][3]);
            *(u32x2*)(o + i * 256 + lane * 4) = w; }
    }
}
__device__ __forceinline__ void phase_final(const bf16_t* xb, float* out, const float* gain) {
    const int tid0 = ltid(); const int wave = tid0 >> 6, lane = tid0 & 63;
    f32x4 g[4];
#pragma unroll
    for (int i = 0; i < 4; ++i) g[i] = *(const f32x4*)(gain + i * 256 + lane * 4);
    for (int row = (BI_ * 8 + wave) * 2; row < T_; row += GD_ * 16) {
        u32x2 t[2][4];
#pragma unroll
        for (int q = 0; q < 2; ++q)
#pragma unroll
            for (int i = 0; i < 4; ++i) t[q][i] = *(const u32x2*)(xb + (size_t)(row + q) * 1024 + i * 256 + lane * 4);
#pragma unroll
        for (int q = 0; q < 2; ++q) {
            f32x4 v[4]; float ss = 0.f;
#pragma unroll
            for (int i = 0; i < 4; ++i) { v[i] = (f32x4){bf_lo(t[q][i].x), bf_hi(t[q][i].x), bf_lo(t[q][i].y), bf_hi(t[q][i].y)}; ss += v[i][0] * v[i][0] + v[i][1] * v[i][1] + v[i][2] * v[i][2] + v[i][3] * v[i][3]; }
            ss = wave_sum(ss); const float rs = rsqrtf(ss * (1.f / 1024.f) + 1e-6f);
#pragma unroll
            for (int i = 0; i < 4; ++i) *(f32x4*)(out + (size_t)(row + q) * 1024 + i * 256 + lane * 4) = v[i] * rs * g[i];
        }
    }
}
__device__ __forceinline__ void phase_r0(const Params& p) {
    const int tid0 = ltid(); const int wave = tid0 >> 6, lane = tid0 & 63;
    const float* x = p.in[I_X]; const float* gain = p.in[I_NMIX]; const float* mu = p.in[I_MU];
    bf16_t* DX = slot(p, 1); bf16_t* XR = slot(p, 2); bf16_t* XK = slot(p, 3); bf16_t* XV = slot(p, 4);
    for (int task = BI_ * 8 + wave; task < T_ / 32; task += GD_ * 8) {
        const int t0 = task * 32;
f32x4 hp[4];
        if ((t0 & (SEQ_ - 1)) == 0) { for (int i = 0; i < 4; ++i) hp[i] = (f32x4){0.f, 0.f, 0.f, 0.f}; }
        else {
            const float* xr = x + (size_t)(t0 - 1) * 1024; float ss = 0.f;
#pragma unroll
            for (int i = 0; i < 4; ++i) { hp[i] = *(const f32x4*)(xr + i * 256 + lane * 4); ss += hp[i][0] * hp[i][0] + hp[i][1] * hp[i][1] + hp[i][2] * hp[i][2] + hp[i][3] * hp[i][3]; }
            ss = wave_sum(ss); const float rs = rsqrtf(ss * (1.f / 1024.f) + 1e-6f);
#pragma unroll
            for (int i = 0; i < 4; ++i) hp[i] = hp[i] * rs * *(const f32x4*)(gain + i * 256 + lane * 4);
        }
        f32x4 vn[4];
#pragma unroll
        for (int i = 0; i < 4; ++i) vn[i] = *(const f32x4*)(x + (size_t)t0 * 1024 + i * 256 + lane * 4);
        for (int r = 0; r < 32; ++r) {
            const size_t ro = (size_t)(t0 + r) * 1024; f32x4 v[4]; float ss = 0.f;
#pragma unroll
            for (int i = 0; i < 4; ++i) { v[i] = vn[i]; ss += v[i][0] * v[i][0] + v[i][1] * v[i][1] + v[i][2] * v[i][2] + v[i][3] * v[i][3]; }
            if (r + 1 < 32) {
#pragma unroll
                for (int i = 0; i < 4; ++i) vn[i] = *(const f32x4*)(x + ro + 1024 + i * 256 + lane * 4);
            }
            ss = wave_sum(ss); const float rs = rsqrtf(ss * (1.f / 1024.f) + 1e-6f);
#pragma unroll
            for (int i = 0; i < 4; ++i) {
                const int c = i * 256 + lane * 4;
                const f32x4 h = v[i] * rs * *(const f32x4*)(gain + c);
                const f32x4 dx = hp[i] - h; hp[i] = h;
                const f32x4 a = h + dx * *(const f32x4*)(mu + 0 * 1024 + c), b = h + dx * *(const f32x4*)(mu + 2 * 1024 + c), d = h + dx * *(const f32x4*)(mu + 3 * 1024 + c);
                u32x2 w;
                w.x = cvt_pk_bf16(dx[0], dx[1]); w.y = cvt_pk_bf16(dx[2], dx[3]); *(u32x2*)(DX + ro + c) = w;
                w.x = cvt_pk_bf16(a[0], a[1]); w.y = cvt_pk_bf16(a[2], a[3]); *(u32x2*)(XR + ro + c) = w;
                w.x = cvt_pk_bf16(b[0], b[1]); w.y = cvt_pk_bf16(b[2], b[3]); *(u32x2*)(XK + ro + c) = w;
                w.x = cvt_pk_bf16(d[0], d[1]); w.y = cvt_pk_bf16(d[2], d[3]); *(u32x2*)(XV + ro + c) = w;
            }
        }
    }
}

typedef short s16x4 __attribute__((ext_vector_type(4)));
typedef __bf16 bf16x2_t __attribute__((ext_vector_type(2)));
__device__ __forceinline__ unsigned cvt2(float lo, float hi) { f32x2 v = {lo, hi}; bf16x2_t b = __builtin_convertvector(v, bf16x2_t); return __builtin_bit_cast(unsigned, b); }
__device__ __forceinline__ s16x4 cvt4(f32x4 x) { u32x2 q = {cvt2(x[0], x[1]), cvt2(x[2], x[3])}; return __builtin_bit_cast(s16x4, q); }
__device__ __forceinline__ unsigned short bfs(float x) { return (unsigned short)(cvt2(x, 0.f) & 0xffffu); }
__device__ __forceinline__ float bfl(unsigned short x) { return __builtin_bit_cast(float, (unsigned)x << 16); }
#define MFMA16(a, b, c) __builtin_amdgcn_mfma_f32_16x16x16bf16_1k((a), (b), (c), 0, 0, 0)
#define MFMA32(a, b, c) __builtin_amdgcn_mfma_f32_16x16x32_bf16((a), (b), (c), 0, 0, 0)
constexpr int RS_ = 144, SM_ = 40;
constexpr int PK_QH = 0, PK_RT = 2304, PK_NH = 4608, PK_MBN = 5248, PK_MK = 5888, PK_BPN = 6528, PK_KP = 8672, PK_VT = 10816, PK_DC = 12960, PK_BYTES = 13312;
constexpr int SCR_QM = 0, SCR_BM = 2304, SCR_KM = 4608, SCR_QT = 6912, SCR_BYTES = 9216, SCAN_SCR_OFF = 8 * PK_BYTES;
static_assert(SCAN_SCR_OFF + 4 * SCR_BYTES + 768 <= LDS_BYTES - 64, "scan LDS");

struct ScanRaw { u32x4 r[2], e[2], k[2], v[2], a[2]; };
__device__ __forceinline__ void scan_load(ScanRaw& x, const bf16_t* Rb, const bf16_t* Wb, const bf16_t* Kb, const bf16_t* Vb, const bf16_t* Ab, size_t base, int lane) {
    const size_t o = base + (size_t)(lane >> 2) * 1024 + (lane & 3) * 16;
#pragma unroll
    for (int q = 0; q < 2; ++q) { x.r[q] = *(const u32x4*)(Rb + o + 8 * q); x.e[q] = *(const u32x4*)(Wb + o + 8 * q); x.k[q] = *(const u32x4*)(Kb + o + 8 * q); x.v[q] = *(const u32x4*)(Vb + o + 8 * q); x.a[q] = *(const u32x4*)(Ab + o + 8 * q); }
}
__device__ __forceinline__ void unpack16(const u32x4 (&u)[2], float (&f)[16]) {
#pragma unroll
    for (int q = 0; q < 2; ++q) { f[8 * q] = bf_lo(u[q].x); f[8 * q + 1] = bf_hi(u[q].x); f[8 * q + 2] = bf_lo(u[q].y); f[8 * q + 3] = bf_hi(u[q].y); f[8 * q + 4] = bf_lo(u[q].z); f[8 * q + 5] = bf_hi(u[q].z); f[8 * q + 6] = bf_lo(u[q].w); f[8 * q + 7] = bf_hi(u[q].w); }
}
__device__ __forceinline__ void st_row16(LAS unsigned char* dst, const float (&t)[16]) {
    u32x4 w0, w1; w0.x = cvt2(t[0], t[1]); w0.y = cvt2(t[2], t[3]); w0.z = cvt2(t[4], t[5]); w0.w = cvt2(t[6], t[7]); w1.x = cvt2(t[8], t[9]); w1.y = cvt2(t[10], t[11]); w1.z = cvt2(t[12], t[13]); w1.w = cvt2(t[14], t[15]);
    *(LAS u32x4*)dst = w0; *(LAS u32x4*)(dst + 16) = w1;
}
__device__ __forceinline__ f32x4 unpk4(const u32x4 (&u)[2], int q) { const unsigned lo = (q & 1) ? u[q >> 1].z : u[q >> 1].x, hi = (q & 1) ? u[q >> 1].w : u[q >> 1].y; return (f32x4){bf_lo(lo), bf_hi(lo), bf_lo(hi), bf_hi(hi)}; }
__device__ __forceinline__ void scan_produce(const ScanRaw& x, LAS unsigned char* pkg, LAS unsigned char* scr, int lane, const LAS float* kkg, const LAS float* kag, const LAS float* rkg, float* bon) {
    const int fr = lane & 15, g = lane >> 4, i = lane >> 2, c0 = (lane & 3) * 16;
    LAS float* cs = (LAS float*)scr;
    cs[lane] = 0.f;
#pragma unroll
    for (int q = 0; q < 4; ++q) *(LAS f32x4*)(cs + (i + 1) * 68 + c0 + 4 * q) = unpk4(x.e, q) * 1.4426950408889634f;
    asm volatile("" ::: "memory");
    { float t[16];
#pragma unroll
      for (int j = 0; j < 16; ++j) t[j] = cs[(j + 1) * 68 + lane];
#pragma unroll
      for (int j = 1; j < 16; ++j) t[j] += t[j - 1];
#pragma unroll
      for (int j = 0; j < 16; ++j) cs[(j + 1) * 68 + lane] = t[j]; }
    asm volatile("" ::: "memory");
    float ss = 0.f;
#pragma unroll
    for (int q = 0; q < 4; ++q) { const f32x4 kkv = unpk4(x.k, q) * *(const LAS f32x4*)(kkg + c0 + 4 * q); ss += kkv[0] * kkv[0] + kkv[1] * kkv[1] + kkv[2] * kkv[2] + kkv[3] * kkv[3]; }
    ss += dpp_mov<0xB1>(ss); ss += dpp_mov<0x4E>(ss);
    const float inv = 1.f / fmaxf(sqrtf(ss), 1e-12f);
    f32x4 cu[4], cm[4], cC[4]; float bsum = 0.f;
#pragma unroll
    for (int q = 0; q < 4; ++q) { cu[q] = *(const LAS f32x4*)(cs + (i + 1) * 68 + c0 + 4 * q); cm[q] = *(const LAS f32x4*)(cs + i * 68 + c0 + 4 * q); cC[q] = *(const LAS f32x4*)(cs + 16 * 68 + c0 + 4 * q); }
    asm volatile("s_waitcnt lgkmcnt(0)" ::: "memory");
#pragma unroll
    for (int q = 0; q < 4; ++q) {
        const f32x4 k4 = unpk4(x.k, q), a4 = unpk4(x.a, q), r4 = unpk4(x.r, q), v4 = unpk4(x.v, q);
        const f32x4 kkp4 = *(const LAS f32x4*)(kkg + c0 + 4 * q), kap4 = *(const LAS f32x4*)(kag + c0 + 4 * q), rk4 = *(const LAS f32x4*)(rkg + c0 + 4 * q);
        float qv[4], btv[4], ktv[4], rtv[4], bpv[4], kpv[4];
#pragma unroll
        for (int s = 0; s < 4; ++s) {
            const float D = __builtin_amdgcn_exp2f(-cu[q][s]), Dm = __builtin_amdgcn_exp2f(-cm[q][s]), iD = __builtin_amdgcn_exp2f(cu[q][s]), DCr = __builtin_amdgcn_exp2f(cu[q][s] - cC[q][s]);
            const float kkv = k4[s] * kkp4[s] * inv, bbv = kkv * a4[s], k2 = k4[s] * (1.f + (a4[s] - 1.f) * kap4[s]);
            qv[s] = kkv * Dm; btv[s] = bbv * iD; ktv[s] = k2 * iD; rtv[s] = r4[s] * D; bpv[s] = -(bbv * DCr); kpv[s] = k2 * DCr; bsum += r4[s] * k2 * rk4[s];
            if (i == 15) *(LAS float*)(pkg + PK_DC + (c0 + 4 * q + s) * 4) = D;
            const int o = (c0 + 4 * q + s) * 32 + (lane & 3) * 32 + i * 2;
            *(LAS unsigned short*)(scr + SCR_QT + o) = bfs(qv[s]); *(LAS unsigned short*)(pkg + PK_VT + o) = bfs(v4[s]);
            *(LAS unsigned short*)(pkg + PK_BPN + o) = bfs(bpv[s]); *(LAS unsigned short*)(pkg + PK_KP + o) = bfs(kpv[s]);
        }
        const int ro = i * RS_ + (c0 + 4 * q) * 2;
        *(LAS u32x2*)(scr + SCR_QM + ro) = (u32x2){cvt2(qv[0], qv[1]), cvt2(qv[2], qv[3])}; *(LAS u32x2*)(scr + SCR_BM + ro) = (u32x2){cvt2(btv[0], btv[1]), cvt2(btv[2], btv[3])};
        *(LAS u32x2*)(scr + SCR_KM + ro) = (u32x2){cvt2(ktv[0], ktv[1]), cvt2(ktv[2], ktv[3])}; *(LAS u32x2*)(pkg + PK_RT + ro) = (u32x2){cvt2(rtv[0], rtv[1]), cvt2(rtv[2], rtv[3])};
    }
    bsum += dpp_mov<0xB1>(bsum); bsum += dpp_mov<0x4E>(bsum);
    if ((lane & 3) == 0) bon[i * 16] = bsum;
    asm volatile("" ::: "memory");
    const f32x4 z4 = {0.f, 0.f, 0.f, 0.f};
    f32x4 L = z4, LT = z4, NkT = z4, MbT = z4, MkT = z4;
#pragma unroll
    for (int kb = 0; kb < 2; ++kb) {
        const int fo = fr * RS_ + kb * 64 + g * 16;
        const bf16x8 fq = *(const LAS bf16x8*)(scr + SCR_QM + fo), fb = *(const LAS bf16x8*)(scr + SCR_BM + fo), fk = *(const LAS bf16x8*)(scr + SCR_KM + fo), frt = *(const LAS bf16x8*)(pkg + PK_RT + fo);
        L = MFMA32(fq, fb, L); LT = MFMA32(fb, fq, LT); NkT = MFMA32(fq, fk, NkT); MbT = MFMA32(frt, fb, MbT); MkT = MFMA32(frt, fk, MkT);
    }
    f32x4 I4;
#pragma unroll
    for (int jj = 0; jj < 4; ++jj) { const int row = 4 * g + jj;
        I4[jj] = (row == fr) ? 1.f : 0.f;
        L[jj] = (fr < row) ? L[jj] : 0.f; LT[jj] = (row < fr) ? LT[jj] : 0.f; NkT[jj] = (fr < row) ? NkT[jj] : 0.f;
        MbT[jj] = (fr <= row) ? -MbT[jj] : 0.f; MkT[jj] = (fr <= row) ? MkT[jj] : 0.f; }
    const s16x4 Lb = cvt4(L), LTb = cvt4(LT);
    const f32x4 L2 = MFMA16(LTb, Lb, z4), L2T = MFMA16(Lb, LTb, z4);
    const f32x4 X1T = I4 - LT;
    const f32x4 X2T = MFMA16(cvt4(I4 + L2), cvt4(X1T), z4);
    const s16x4 L2b = cvt4(L2), L2Tb = cvt4(L2T);
    const f32x4 L4 = MFMA16(L2Tb, L2b, z4), L4T = MFMA16(L2b, L2Tb, z4);
    const f32x4 X3T = MFMA16(cvt4(I4 + L4), cvt4(X2T), z4);
    const f32x4 L8 = MFMA16(cvt4(L4T), cvt4(L4), z4);
    const f32x4 X4T = MFMA16(cvt4(I4 + L8), cvt4(X3T), z4);
    const s16x4 TA = cvt4(X4T);
    const f32x4 Nh = MFMA16(TA, cvt4(NkT), z4);
#pragma unroll
    for (int kb = 0; kb < 4; ++kb) {
        const s16x4 qf = *(const LAS s16x4*)(scr + SCR_QT + (16 * kb + fr) * 32 + kb * 32 + g * 8);
        const f32x4 Qh = MFMA16(TA, qf, z4);
#pragma unroll
        for (int jj = 0; jj < 4; ++jj) *(LAS unsigned short*)(pkg + PK_QH + (4 * g + jj) * RS_ + (16 * kb + fr) * 2) = bfs(Qh[jj]);
    }
#pragma unroll
    for (int jj = 0; jj < 4; ++jj) { const int o = (4 * g + jj) * SM_ + fr * 2;
        *(LAS unsigned short*)(pkg + PK_NH + o) = bfs(Nh[jj]); *(LAS unsigned short*)(pkg + PK_MBN + o) = bfs(MbT[jj]); *(LAS unsigned short*)(pkg + PK_MK + o) = bfs(MkT[jj]); }
}

__device__ __forceinline__ void phase_scan(const Params& p, LAS unsigned char* lds) {
    const int tid = ltid(), wave = tid >> 6, lane = tid & 63, fr = lane & 15, g = lane >> 4;
    const bf16_t* Rb = slot(p, 5); const bf16_t* Kb = slot(p, 6); const bf16_t* Vb = (const bf16_t*)p.out;
    const bf16_t* Wb = slot(p, 2); const bf16_t* Ab = slot(p, 3);
    bf16_t* Ob = slot(p, 0);
    for (int unit = BI_; unit < 128; unit += GD_) {
        const int b = unit >> 4, h = unit & 15, pw = wave & 3;
        LAS float* par = (LAS float*)(lds + SCAN_SCR_OFF + 4 * SCR_BYTES);
        const LAS float* kkg = par; const LAS float* kag = par + 64; const LAS float* rkg = par + 128;
        float* bong = (float*)(p.ws + WS_BON) + ((size_t)b * SEQ_) * 16 + h;
        ScanRaw cur, nxt;
        const size_t hbase = ((size_t)b * SEQ_) * 1024 + h * 64;
        LAS unsigned char* scr = lds + SCAN_SCR_OFF + pw * SCR_BYTES;
        __syncthreads();
        if (tid < 192) par[tid] = (tid < 64 ? p.in[I_KK] : tid < 128 ? p.in[I_KA] : p.in[I_RK])[h * 64 + (tid & 63)];
        __syncthreads();
        if (wave >= 4) { scan_load(cur, Rb, Wb, Kb, Vb, Ab, hbase + (size_t)(pw * 16) * 1024, lane); scan_load(nxt, Rb, Wb, Kb, Vb, Ab, hbase + (size_t)((4 + pw) * 16) * 1024, lane);
                         scan_produce(cur, lds + pw * PK_BYTES, scr, lane, kkg, kag, rkg, bong + (size_t)(pw * 16) * 16); cur = nxt; }
        __syncthreads();
        const f32x4 z4 = {0.f, 0.f, 0.f, 0.f};
        f32x4 G[4] = {z4, z4, z4, z4};
        for (int R = 0; R < SEQ_ / 64; ++R) {
            if (wave < 4) {
#pragma unroll 1
                for (int qq = 0; qq < 4; ++qq) {
                    const LAS unsigned char* pk = lds + ((R & 1) * 4 + qq) * PK_BYTES;
                    const s16x4 vt = *(const LAS s16x4*)(pk + PK_VT + (16 * wave + fr) * 32 + wave * 32 + g * 8);
                    s16x4 Gb[4];
#pragma unroll
                    for (int kb = 0; kb < 4; ++kb) Gb[kb] = cvt4(G[kb]);
                    f32x4 PT = MFMA16(*(const LAS s16x4*)(pk + PK_NH + fr * SM_ + g * 8), vt, z4);
                    f32x4 OT = MFMA16(*(const LAS s16x4*)(pk + PK_MK + fr * SM_ + g * 8), vt, z4);
#pragma unroll
                    for (int kb = 0; kb < 4; ++kb) {
                        PT = MFMA16(*(const LAS s16x4*)(pk + PK_QH + fr * RS_ + (16 * kb + 4 * g) * 2), Gb[kb], PT);
                        OT = MFMA16(*(const LAS s16x4*)(pk + PK_RT + fr * RS_ + (16 * kb + 4 * g) * 2), Gb[kb], OT);
                    }
                    const s16x4 PTb = cvt4(PT);
                    OT = MFMA16(*(const LAS s16x4*)(pk + PK_MBN + fr * SM_ + g * 8), PTb, OT);
#pragma unroll
                    for (int kb = 0; kb < 4; ++kb) {
                        const f32x4 dc = *(const LAS f32x4*)(pk + PK_DC + (16 * kb + 4 * g) * 4);
                        f32x4 t = G[kb] * dc;
                        t = MFMA16(*(const LAS s16x4*)(pk + PK_BPN + (16 * kb + fr) * 32 + kb * 32 + g * 8), PTb, t);
                        G[kb] = MFMA16(*(const LAS s16x4*)(pk + PK_KP + (16 * kb + fr) * 32 + kb * 32 + g * 8), vt, t);
                    }
                    bf16_t* op = Ob + hbase + (size_t)((R * 4 + qq) * 16 + 4 * g) * 1024 + 16 * wave + fr;
#pragma unroll
                    for (int jj = 0; jj < 4; ++jj) { const float nb = dpp_mov<0xB1>(OT[jj]); const unsigned w2 = cvt2(OT[jj], nb); if ((fr & 1) == 0) *(unsigned*)(op + (size_t)jj * 1024) = w2; }
                }
            } else if (R + 1 < SEQ_ / 64) {
                if (R + 2 < SEQ_ / 64) scan_load(nxt, Rb, Wb, Kb, Vb, Ab, hbase + (size_t)(((R + 2) * 4 + pw) * 16) * 1024, lane);
                scan_produce(cur, lds + (((R + 1) & 1) * 4 + pw) * PK_BYTES, scr, lane, kkg, kag, rkg, bong + (size_t)(((R + 1) * 4 + pw) * 16) * 16); cur = nxt;
            }
            __syncthreads();
        }
    }
}
__device__ __forceinline__ void phase_post(const Params& p) {
    const bf16_t* Vb = (const bf16_t*)p.out; bf16_t* Gb = slot(p, 4);
    const bf16_t* Ob = slot(p, 0); const float* Bon = (const float*)(p.ws + WS_BON);
    const size_t total = (size_t)T_ * 256, stride = (size_t)GD_ * 512;
    const int tid0 = ltid();
    for (size_t g0 = (size_t)BI_ * 512 + tid0; g0 < total; g0 += 2 * stride) {
        u32x2 o2[2]; u32x2 uv2[2], ug2[2]; float bs2[2]; bool ok[2];
#pragma unroll
        for (int q = 0; q < 2; ++q) { const size_t gid = g0 + q * stride; ok[q] = gid < total; const size_t eo = (ok[q] ? gid : g0) * 4;
            o2[q] = *(const u32x2*)(Ob + eo); uv2[q] = *(const u32x2*)(Vb + eo); ug2[q] = *(const u32x2*)(Gb + eo); bs2[q] = Bon[(ok[q] ? gid : g0) >> 4]; }
#pragma unroll
        for (int q = 0; q < 2; ++q) {
            const size_t gid = g0 + q * stride; const size_t eo = gid * 4; const int ch = (int)(gid & 255) * 4;
            const f32x4 o = {bf_lo(o2[q].x), bf_hi(o2[q].x), bf_lo(o2[q].y), bf_hi(o2[q].y)}; const u32x2 uv = uv2[q], ug = ug2[q]; const float bs = bs2[q];
            const f32x4 v4 = {bf_lo(uv.x), bf_hi(uv.x), bf_lo(uv.y), bf_hi(uv.y)}, g4 = {bf_lo(ug.x), bf_hi(ug.x), bf_lo(ug.y), bf_hi(ug.y)};
            const f32x4 lg = *(const f32x4*)(p.in[I_LNXG] + ch), lb = *(const f32x4*)(p.in[I_LNXB] + ch);
            float s = o[0] + o[1] + o[2] + o[3];
            s += dpp_mov<0xB1>(s); s += dpp_mov<0x4E>(s); s += dpp_mov<0x141>(s); s += dpp_mov<0x140>(s);
            const float mean = s * (1.f / 64.f);
            const f32x4 d = o - mean; float qq = d[0] * d[0] + d[1] * d[1] + d[2] * d[2] + d[3] * d[3];
            qq += dpp_mov<0xB1>(qq); qq += dpp_mov<0x4E>(qq); qq += dpp_mov<0x141>(qq); qq += dpp_mov<0x140>(qq);
            const float rstd = rsqrtf(qq * (1.f / 64.f) + 64e-5f);
            const f32x4 y = (d * rstd * lg + lb + bs * v4) * g4;
            u32x2 w; w.x = cvt_pk_bf16(y[0], y[1]); w.y = cvt_pk_bf16(y[2], y[3]);
            if (ok[q]) *(u32x2*)(Gb + eo) = w;
        }
    }
}

__device__ __forceinline__ void phase_conv(const Params& p, int l) {
    const bf16_t* Gt = slot(p, 1); bf16_t* Vl = slot(p, 1) + (size_t)T_ * FF_;
    const float* cw = p.in[I_CONVW] + (size_t)l * 3 * FF_; const float* cb = p.in[I_CONVB] + (size_t)l * FF_;
    constexpr int CH = FF_ / 8, RUN = 32;
    const int total = (T_ / RUN) * CH;
    const int tid0 = ltid();
    for (int id = BI_ * 512 + tid0; id < total; id += GD_ * 512) {
        const int cc = (id % CH) * 8, t0 = (id / CH) * RUN;
        float w0[8], w1[8], w2[8], bb[8], g1[8], g2[8];
#pragma unroll
        for (int e = 0; e < 8; ++e) { w0[e] = cw[cc + e]; w1[e] = cw[FF_ + cc + e]; w2[e] = cw[2 * FF_ + cc + e]; bb[e] = cb[cc + e]; g1[e] = 0.f; g2[e] = 0.f; }
        if ((t0 & (SEQ_ - 1)) != 0) {
            const u32x4 a = *(const u32x4*)(Gt + (size_t)(t0 - 1) * FF_ + cc), b = *(const u32x4*)(Gt + (size_t)(t0 - 2) * FF_ + cc);
            g1[0] = bf_lo(a.x); g1[1] = bf_hi(a.x); g1[2] = bf_lo(a.y); g1[3] = bf_hi(a.y); g1[4] = bf_lo(a.z); g1[5] = bf_hi(a.z); g1[6] = bf_lo(a.w); g1[7] = bf_hi(a.w);
            g2[0] = bf_lo(b.x); g2[1] = bf_hi(b.x); g2[2] = bf_lo(b.y); g2[3] = bf_hi(b.y); g2[4] = bf_lo(b.z); g2[5] = bf_hi(b.z); g2[6] = bf_lo(b.w); g2[7] = bf_hi(b.w);
        }
        for (int r = 0; r < RUN; ++r) {
            const size_t o = (size_t)(t0 + r) * FF_ + cc;
            const u32x4 a = *(const u32x4*)(Gt + o), vv = *(const u32x4*)(Vl + o);
            float g0[8] = {bf_lo(a.x), bf_hi(a.x), bf_lo(a.y), bf_hi(a.y), bf_lo(a.z), bf_hi(a.z), bf_lo(a.w), bf_hi(a.w)};
            float v8[8] = {bf_lo(vv.x), bf_hi(vv.x), bf_lo(vv.y), bf_hi(vv.y), bf_lo(vv.z), bf_hi(vv.z), bf_lo(vv.w), bf_hi(vv.w)};
            float hh[8];
#pragma unroll
            for (int e = 0; e < 8; ++e) { const float cv = g2[e] * w0[e] + g1[e] * w1[e] + g0[e] * w2[e] + bb[e]; hh[e] = cv * sigmoidf_(cv) * v8[e]; g2[e] = g1[e]; g1[e] = g0[e]; }
            u32x4 w; w.x = cvt_pk_bf16(hh[0], hh[1]); w.y = cvt_pk_bf16(hh[2], hh[3]); w.z = cvt_pk_bf16(hh[4], hh[5]); w.w = cvt_pk_bf16(hh[6], hh[7]);
            *(u32x4*)(Vl + o) = w;
        }
    }
}

__device__ __forceinline__ void phase_sgu(const Params& p, LAS unsigned char* lds) {
    LAS float* stats = (LAS float*)lds;
    LAS unsigned short* vTb = (LAS unsigned short*)(lds + 1024);
    const bf16_t* U = slot(p, 1); const bf16_t* V = slot(p, 2); bf16_t* Go = slot(p, 3);
    const bf16_t* Ws = wsW(p, W_GS);
    const int tid = ltid(), wave = tid >> 6, lane = tid & 63, fr = lane & 15, fq = lane >> 4;
    const int ls = tid >> 2, dq = (tid & 3) * 16;
    for (int unit = BI_; unit < T_ / 128; unit += GD_) {
        const size_t t0 = (size_t)unit * 128;
        __syncthreads();
        { const int row = tid >> 2, q = tid & 3; const f32x2 pr = *(const f32x2*)(p.out + (t0 + row) * 8 + q * 2); float s = pr.x, ss = pr.y;
          s += __shfl_xor(s, 1, 64); s += __shfl_xor(s, 2, 64); ss += __shfl_xor(ss, 1, 64); ss += __shfl_xor(ss, 2, 64);
          const float mean = s * (1.f / 1024.f), var = fmaxf(ss * (1.f / 1024.f) - mean * mean, 0.f);
          if (q == 0) { stats[row * 2] = mean; stats[row * 2 + 1] = rsqrtf(var + 1e-5f); } }
        const bf16_t* vrow = V + (t0 + ls) * 1024 + dq;
        u32x4 raw0 = *(const u32x4*)(vrow), raw1 = *(const u32x4*)(vrow + 8);
        f32x4 lgv[4], lbv[4];
#pragma unroll
        for (int i = 0; i < 4; ++i) { lgv[i] = *(const f32x4*)(p.in[I_GLNG] + dq + 4 * i); lbv[i] = *(const f32x4*)(p.in[I_GLNB] + dq + 4 * i); }
        __syncthreads();
        const float mean = stats[ls * 2], rstd = stats[ls * 2 + 1];
        const int t = 16 * wave + fr;
        for (int g = 0; g < 16; ++g) {
            LAS unsigned short* vT = vTb + (g & 1) * (64 * 136);
            u32x2 uu[4];
#pragma unroll
            for (int n = 0; n < 4; ++n) uu[n] = *(const u32x2*)(U + (t0 + t) * 1024 + g * 64 + n * 16 + fq * 4);
            const int kmax = (16 * wave + 15) >> 5;
            bf16x8 afv[4];
#pragma unroll
            for (int kk = 0; kk < 4; ++kk) if (kk <= kmax) afv[kk] = *(const bf16x8*)(Ws + ((size_t)g * 128 + 16 * wave + fr) * 128 + kk * 32 + fq * 8);
            const float bias = p.in[I_GBS][g * 128 + t];
            {
#pragma unroll
              for (int i = 0; i < 2; ++i) { const u32x4 a = i ? raw1 : raw0;
                  const float f[8] = {bf_lo(a.x), bf_hi(a.x), bf_lo(a.y), bf_hi(a.y), bf_lo(a.z), bf_hi(a.z), bf_lo(a.w), bf_hi(a.w)};
#pragma unroll
                  for (int e = 0; e < 8; ++e) vT[(dq + i * 8 + e) * 136 + ls] = bf1((f[e] - mean) * rstd * lgv[i * 2 + (e >> 2)][e & 3] + lbv[i * 2 + (e >> 2)][e & 3]); } }
            if (g + 1 < 16) { raw0 = *(const u32x4*)(vrow + (g + 1) * 64); raw1 = *(const u32x4*)(vrow + (g + 1) * 64 + 8);
#pragma unroll
                for (int i = 0; i < 4; ++i) { lgv[i] = *(const f32x4*)(p.in[I_GLNG] + (g + 1) * 64 + dq + 4 * i); lbv[i] = *(const f32x4*)(p.in[I_GLNB] + (g + 1) * 64 + dq + 4 * i); } }
            asm volatile("s_waitcnt lgkmcnt(0)" ::: "memory"); __builtin_amdgcn_s_barrier(); asm volatile("" ::: "memory");
            f32x4 acc[4];
#pragma unroll
            for (int n = 0; n < 4; ++n) acc[n] = (f32x4){0.f, 0.f, 0.f, 0.f};
#pragma unroll
            for (int kk = 0; kk < 4; ++kk) if (kk <= kmax) {
#pragma unroll
                for (int n = 0; n < 4; ++n) { const bf16x8 bfr = *(const LAS bf16x8*)(vT + (n * 16 + fr) * 136 + kk * 32 + fq * 8);
                    acc[n] = __builtin_amdgcn_mfma_f32_16x16x32_bf16(bfr, afv[kk], acc[n], 0, 0, 0); }
            }
            {
#pragma unroll
              for (int n = 0; n < 4; ++n) { const size_t o = (t0 + t) * 1024 + g * 64 + n * 16 + fq * 4;
                  u32x2 w; w.x = cvt_pk_bf16(bf_lo(uu[n].x) * (acc[n][0] + bias), bf_hi(uu[n].x) * (acc[n][1] + bias)); w.y = cvt_pk_bf16(bf_lo(uu[n].y) * (acc[n][2] + bias), bf_hi(uu[n].y) * (acc[n][3] + bias));
                  *(u32x2*)(Go + o) = w; } }
        }
    }
}

#define XB_TMO      128
#define XB_XCNT(j)  (256  + 64 * (j))
#define XB_XSUB(j)  (1280 + 64 * (j))
#define XB_XGEN(j)  (2304 + 64 * (j))
#define XB_TOP      3328
#define XB_TOPGEN   3392
#define XCD_BAR_WORDS 3456
#define XB_SPIN_CAP (1u << 18)

__device__ __forceinline__ unsigned xb_ld(unsigned* p)              { return __hip_atomic_load(p, __ATOMIC_RELAXED, __HIP_MEMORY_SCOPE_AGENT); }
__device__ __forceinline__ unsigned xb_add(unsigned* p, unsigned v) { return __hip_atomic_fetch_add(p, v, __ATOMIC_RELAXED, __HIP_MEMORY_SCOPE_AGENT); }
__device__ __forceinline__ unsigned xb_xcc_id() { return (unsigned)__builtin_amdgcn_s_getreg((3 << 11) | 20) & 0xFu; }
#define XB_SPIN(cond, bar) do { unsigned _sp = 0; while (cond) { __builtin_amdgcn_s_sleep(1); \
    if ((++_sp & 255u) == 0u) { if (xb_ld(&(bar)[XB_TMO])) break; if (_sp > XB_SPIN_CAP) { atomicAdd(&(bar)[XB_TMO], 1u); break; } } } } while (0)

struct XcdBarrier {
    unsigned* bar; unsigned x;
    volatile LAS unsigned* st;
};

__device__ __forceinline__ XcdBarrier xcd_barrier_post(unsigned* bar, volatile LAS unsigned* st) {
    XcdBarrier b; b.bar = bar; b.x = xb_xcc_id(); b.st = st;
    if (threadIdx.x == 0) (void)xb_add(&bar[XB_XCNT(b.x)], 1u);
    return b;
}
__device__ __forceinline__ void xcd_barrier_complete(unsigned* bar, unsigned x, unsigned& nloc, unsigned& nx) {
    const unsigned G = gridDim.x * gridDim.y * gridDim.z;
    unsigned sum, cnt, mine, sp = 0u;
    for (;;) {
        sum = 0u; cnt = 0u; mine = 0u;
#pragma unroll
        for (unsigned j = 0; j < 16; ++j) { const unsigned c = xb_ld(&bar[XB_XCNT(j)]); sum += c; cnt += (c > 0u) ? 1u : 0u; mine = (j == x) ? c : mine; }
        if (sum == G) break;
        __builtin_amdgcn_s_sleep(1);
        if ((++sp & 255u) == 0u) { if (xb_ld(&bar[XB_TMO])) break; if (sp > XB_SPIN_CAP) { atomicAdd(&bar[XB_TMO], 1u); break; } }
    }
    nloc = mine > 0u ? mine : 1u; nx = cnt > 0u ? cnt : 1u;
}

__device__ __forceinline__ void xcd_barrier(const XcdBarrier& b) {
    asm volatile("s_waitcnt vmcnt(0)" ::: "memory");
    __syncthreads();
    if (threadIdx.x == 0) {
        unsigned* bar = b.bar;
        __builtin_amdgcn_s_waitcnt(0);
        unsigned nloc = b.st[0], nx = b.st[1];
        if (nloc == 0u) { xcd_barrier_complete(bar, b.x, nloc, nx); b.st[0] = nloc; b.st[1] = nx; }
        const unsigned old = xb_add(&bar[XB_XSUB(b.x)], 1u);
        const unsigned gen = old / nloc;
        if (old + 1u == (gen + 1u) * nloc) {
            __builtin_amdgcn_fence(__ATOMIC_RELEASE, "agent");
            asm volatile("s_waitcnt vmcnt(0)" ::: "memory");
            const unsigned og = xb_add(&bar[XB_TOP], 1u);
            const unsigned tg = og / nx;
            if (og + 1u == (tg + 1u) * nx) xb_add(&bar[XB_TOPGEN], 1u);
            else XB_SPIN(xb_ld(&bar[XB_TOPGEN]) == tg, bar);
            __builtin_amdgcn_fence(__ATOMIC_ACQUIRE, "agent");
            xb_add(&bar[XB_XGEN(b.x)], 1u);
            asm volatile("s_waitcnt vmcnt(0)" ::: "memory");
        } else {
            XB_SPIN(xb_ld(&bar[XB_XGEN(b.x)]) == gen, bar);
            __builtin_amdgcn_fence(__ATOMIC_ACQUIRE, "agent");
            asm volatile("s_waitcnt vmcnt(0)" ::: "memory");
        }
    }
    __syncthreads();
}

__device__ __forceinline__ pg8::Gemm mk_gemm(const bf16_t* A, const bf16_t* Bt, int lda, int ldb, int K, int nM, int nN) {
    pg8::Gemm g; g.A = A; g.Bt = Bt; g.lda = lda; g.ldb = ldb; g.K = K; g.nM = nM; g.nN = nN; g.nZ = 1; g.zdiv = 1; g.zA1 = g.zA2 = g.zB1 = g.zB2 = 0; g.ksplit = 1 << 30; g.adelta = 0; g.ovl = 0; g.koffpn = 1 << 30; g.koff = 0; g.pm0 = 0; return g;
}
__device__ __forceinline__ pg8::EpiBfData mk_epi(bf16_t* O, int ldc) {
    pg8::EpiBfData e; e.O = O; e.ldc = ldc; e.zdiv = 1; e.zO1 = e.zO2 = 0; e.split_cols = 0; e.split_stride = 0; e.p0 = nullptr; e.p1 = nullptr; e.scale = 1.f; e.ss = nullptr; e.vs = nullptr; e.red = nullptr; return e;
}
constexpr int N_STEPS = 34;
__device__ __forceinline__ bool need_sync(int st) { return !(st == 2 || st == 3 || st == 5 || st == 6); }
__device__ __forceinline__ bool skip_step(int st) { return st == 1 || st == 2 || (MK_ONE_LAUNCH && (st == 19 || st == 32)) || st == 11 || st == 16 || st == 20 || st == 24 || st == 29 || st == 18 || st == 31; }
enum { K_NONE = 0, K_BF, K_LORA1, K_LORA2, K_GELU, K_RES, K_SOFTMAX, K_CONV };
struct Desc { pg8::Gemm g; pg8::EpiBfData e; const float* res; float* ssw; int kind; };
__device__ __forceinline__ void get_desc(const Params& p, int st, Desc& d) {
    const bf16_t* MEMN = (const bf16_t*)(p.ws + WS_MEMN); bf16_t* KM = (bf16_t*)(p.ws + WS_KM); bf16_t* VT = (bf16_t*)(p.ws + WS_VT);
    bf16_t* LMID = (bf16_t*)p.out + (size_t)T_ * 1024; float* SS = (float*)(p.ws + WS_SS);
    int l = 0, cs = -1;
    if (st >= 11 && st <= 19) cs = st - 11; else if (st >= 24 && st <= 32) { cs = st - 24; l = 1; }
    int kind = K_NONE; pg8::Gemm g = mk_gemm(nullptr, nullptr, 0, 0, 0, 0, 0); pg8::EpiBfData e = mk_epi(nullptr, 0);
    const float* res = nullptr; float* ssw = nullptr;
    if (st == 1) { g = mk_gemm(MEMN, wsW(p, W_CAKV), 1024, 1024, 1024, 8, 4); g.nZ = 2; g.zB1 = 2 * Mi; e = mk_epi(KM, 1024); e.zO1 = 2 * Mi; kind = K_BF; }
    else if (st == 2) { g = mk_gemm(wsW(p, W_CAKV + Mi), MEMN, 1024, 1024, 1024, 4, 1); g.nZ = 16; g.zdiv = 8; g.zA1 = 2 * Mi; g.zB2 = 256 * 1024;
                        e = mk_epi(VT, 256); e.zdiv = 8; e.zO1 = 2 * Mi; e.zO2 = 1024 * 256; kind = K_BF; }
    else if (st == 4) { g = mk_gemm(slot(p, 2), wsW(p, W_RKV), 1024, 1024, 1024, 256, 4); g.nZ = 2; g.zA1 = (long)(SLOT / 2); g.zB1 = (long)Mi; e = mk_epi(slot(p, 5), 1024); e.zO1 = (long)(SLOT / 2); kind = K_BF; }
    else if (st == 5) { g = mk_gemm(slot(p, 4), wsW(p, W_RKV + 2 * Mi), 1024, 1024, 1024, 256, 4); e = mk_epi((bf16_t*)p.out, 1024); kind = K_BF; }
    else if (st == 6) { g = mk_gemm(slot(p, 2), wsW(p, W_L1), 1024, 2048, 2048, 256, 1); g.ksplit = 16; g.adelta = -(long)SLOT - 2048; e = mk_epi(LMID, 256); kind = K_LORA1; }
    else if (st == 7) { g = mk_gemm(LMID, wsW(p, W_L2), 256, 256, 128, 256, 12); g.koffpn = 8; g.koff = 128;   e = mk_epi(slot(p, 2), 1024); e.split_cols = 1024; e.split_stride = (long)(SLOT / 2); e.p0 = p.in[I_W0]; e.p1 = p.in[I_A0]; kind = K_LORA2; }
    else if (st == 10) { g = mk_gemm(slot(p, 4), wsW(p, W_RWO), 1024, 1024, 1024, 256, 4); res = p.in[I_X]; ssw = SS; kind = K_RES; }
    else if (cs == 1) { g = mk_gemm(slot(p, 0), wsW(p, W_CAQ + l * Mi), 1024, 1024, 1024, 256, 4); e = mk_epi(slot(p, 1), 1024); e.scale = 0.0625f; e.ss = SS + (l ? 3 : 0) * 4 * T_; kind = K_BF; }
    else if (cs == 2) { g = mk_gemm(slot(p, 1), KM + (size_t)l * 2 * Mi, 1024, 1024, 256, 32, 1); g.nZ = 32; g.zdiv = 4; g.zA1 = (long)SEQ_ * 1024; g.zA2 = 256; g.zB1 = 256 * 1024; g.zB2 = 256; kind = K_SOFTMAX; }
    else if (cs == 3) { g = mk_gemm(slot(p, 2), VT + (size_t)l * 2 * Mi, 1024, 256, 256, 32, 1); g.nZ = 32; g.zdiv = 4; g.zA1 = (long)SEQ_ * 1024; g.zA2 = 256; g.zB1 = 1024 * 256; g.zB2 = 256 * 256;
                        e = mk_epi(slot(p, 3), 1024); e.zdiv = 4; e.zO1 = (long)SEQ_ * 1024; e.zO2 = 256; kind = K_BF; }
    else if (cs == 4) { g = mk_gemm(slot(p, 3), wsW(p, W_CAO + l * Mi), 1024, 1024, 1024, 256, 4); ssw = SS + (l ? 4 : 1) * 4 * T_; kind = K_RES; }
    else if (cs == 6) { g = mk_gemm(slot(p, 0), wsW(p, W_UP + (size_t)l * 5632 * 1024), 1024, 1024, 1024, 264, 22); g.ovl = 1; e.ss = SS + (l ? 4 : 1) * 4 * T_; e.p0 = p.in[I_CONVW] + (size_t)l * 3 * FF_; e.p1 = p.in[I_CONVB] + (size_t)l * FF_; kind = K_CONV; }
    else if (cs == 8) { g = mk_gemm(slot(p, 1), wsW(p, W_DOWN + (size_t)l * 2816 * 1024), FF_, FF_, FF_, 256, 4); if (l == 0) ssw = SS + 2 * 4 * T_; kind = K_RES; }
    else if (st == 21) { g = mk_gemm(slot(p, 0), wsW(p, W_GIN), 1024, 1024, 1024, 256, 8); e = mk_epi(slot(p, 1), 1024); e.split_cols = 1024; e.split_stride = (long)(SLOT / 2); e.ss = SS + 2 * 4 * T_; kind = K_GELU; }
    else if (st == 23) { g = mk_gemm(slot(p, 3), wsW(p, W_GOUT), 1024, 1024, 1024, 256, 4); ssw = SS + 3 * 4 * T_; kind = K_RES; }
    d.g = g; d.e = e; d.res = res; d.ssw = ssw; d.kind = kind;
}
namespace pg8 {
template <int OP> struct MakeEpi<EpiBf<OP>> { static __device__ __forceinline__ EpiBf<OP> make(const Params& p, int st, LAS unsigned char* lds) { Desc d; get_desc(p, st, d); EpiBf<OP> E; (EpiBfData&)E = d.e; E.red = (LAS float*)(lds + EXTRA_OFF); E.vs = (OP == OP_GELU) ? p.out : nullptr; return E; } };
template <> struct MakeEpi<EpiRes> { static __device__ __forceinline__ EpiRes make(const Params& p, int st, LAS unsigned char* lds) { Desc d; get_desc(p, st, d); return EpiRes{d.res, slot(p, 0), d.ssw, 1024, (LAS float*)(lds + EXTRA_OFF)}; } };
template <> struct MakeEpi<EpiConv> { static __device__ __forceinline__ EpiConv make(const Params& p, int st, LAS unsigned char* lds) { Desc d; get_desc(p, st, d); return EpiConv{slot(p, 1), d.e.p0, d.e.p1, d.e.ss, (LAS float*)(lds + EXTRA_OFF)}; } };
template <> struct MakeEpi<EpiSoftmax> { static __device__ __forceinline__ EpiSoftmax make(const Params& p, int, LAS unsigned char* lds) { return EpiSoftmax{slot(p, 2), (LAS float*)(lds + EXTRA_OFF)}; } };
}

__global__ void __launch_bounds__(512) mega(Params p) {
    extern __shared__ __attribute__((aligned(16))) unsigned char lds_raw[];
    LAS unsigned char* lds = (LAS unsigned char*)lds_raw;
    cg::grid_group grid = cg::this_grid();
#if MK_ONE_LAUNCH
    volatile LAS unsigned* xst = (volatile LAS unsigned*)(lds + LDS_BYTES - 64);
    if (threadIdx.x == 0) { xst[0] = 0u; xst[1] = 0u; }
    __syncthreads();
    const XcdBarrier xbar = xcd_barrier_post((unsigned*)(p.ws + WS_BAR), xst);
    for (int st = p.ph_lo; st < p.ph_hi; ++st) {
      if (skip_step(st)) continue;
      const int reps = 1 + (int)(((unsigned long long)(REP_MASK) >> st) & 1ull);
      for (int rep = 0; rep < reps; ++rep) {
        if ((st > p.ph_lo && need_sync(st)) || rep > 0) { if (st == 4 && rep == 0) grid.sync(); else xcd_barrier(xbar); }
#else
    { { const int st = p.ph_lo;
#endif
        const int l = (st >= 24) ? 1 : 0;
        if (st == 0) phase_prologue(p, lds);
        else if (st == 3) phase_r0(p);
        else if (st == 8) { if (BI_ < 128 || GD_ <= 128) phase_scan(p, lds); if (GD_ <= 128) { phase_convert_late(p, lds, BI_, GD_); __syncthreads();
                                 Desc d1; get_desc(p, 1, d1); pg8::gemm_phase<pg8::EpiBf<pg8::OP_NONE>, false>(lds, d1.g, p, 1);
                                 Desc d2; get_desc(p, 2, d2); pg8::gemm_phase<pg8::EpiBf<pg8::OP_NONE>, false>(lds, d2.g, p, 2); }
                            else if (BI_ >= 128) { phase_convert_late(p, lds, BI_ - 128, GD_ - 128); __syncthreads();
                                 Desc d1; get_desc(p, 1, d1); pg8::gemm_phase<pg8::EpiBf<pg8::OP_NONE>, false>(lds, d1.g, p, 1, GD_ - 128, BI_ - 128);
                                 Desc d2; get_desc(p, 2, d2); pg8::gemm_phase<pg8::EpiBf<pg8::OP_NONE>, false>(lds, d2.g, p, 2, GD_ - 128, BI_ - 128); } }
        else if (st == 9) phase_post(p);
        else if (st == 22) phase_sgu(p, lds);
        else if (st == 33) phase_final(slot(p, 0), p.out, p.in[I_NFIN]);
        else {
            Desc d; get_desc(p, st, d);
            if (d.kind == K_BF) pg8::gemm_phase<pg8::EpiBf<pg8::OP_NONE>, false>(lds, d.g, p, st);
            else if (d.kind == K_LORA1) pg8::gemm_phase<pg8::EpiBf<pg8::OP_LORA1>, true>(lds, d.g, p, st);
            else if (d.kind == K_LORA2) pg8::gemm_phase<pg8::EpiBf<pg8::OP_LORA2>, false>(lds, d.g, p, st);
            else if (d.kind == K_GELU) pg8::gemm_phase<pg8::EpiBf<pg8::OP_GELU>, false>(lds, d.g, p, st);
            else if (d.kind == K_RES) pg8::gemm_phase<pg8::EpiRes, false>(lds, d.g, p, st);
            else if (d.kind == K_SOFTMAX) pg8::gemm_phase<pg8::EpiSoftmax, false>(lds, d.g, p, st);
#if MK_ONE_LAUNCH
            else if (d.kind == K_CONV) {
                for (int half = 0; half < 2; ++half) {
                    pg8::Gemm gu = d.g; gu.nM = 132; gu.pm0 = 132 * half; pg8::gemm_phase<pg8::EpiConv, false>(lds, gu, p, st);
                    xcd_barrier(xbar);
                    Desc dd; get_desc(p, st + 2, dd); pg8::Gemm gd = dd.g; gd.nM = 128; gd.pm0 = 128 * half; pg8::gemm_phase<pg8::EpiRes, false>(lds, gd, p, st + 2);
                    if (half == 0) xcd_barrier(xbar);
                }
            }
#else
            else if (d.kind == K_CONV) pg8::gemm_phase<pg8::EpiConv, false>(lds, d.g, p, st);
#endif
        }
    } }
}

extern "C" void kernel_launch(void* const* d_in, const int* in_sizes, int n_in, void* d_out, int out_size, void* d_ws, size_t ws_size, hipStream_t stream) {
    static int grid = 0;
    if (grid == 0) {
        int dev = 0, cus = 0, per_cu = 0;
        (void)hipGetDevice(&dev); (void)hipDeviceGetAttribute(&cus, hipDeviceAttributeMultiprocessorCount, dev);
        if (hipFuncSetAttribute((const void*)mega, hipFuncAttributeMaxDynamicSharedMemorySize, LDS_BYTES) != hipSuccess) fprintf(stderr, "kernel_launch: hipFuncSetAttribute failed\n");
        if (hipOccupancyMaxActiveBlocksPerMultiprocessor(&per_cu, (const void*)mega, 512, LDS_BYTES) != hipSuccess || per_cu < 1) { fprintf(stderr, "kernel_launch: occupancy query gave %d\n", per_cu); per_cu = 1; }
        (void)hipGetLastError();
        grid = cus * per_cu; if (grid <= 0) grid = 256;
    }
    Params p{};
    for (int i = 0; i < 36; ++i) p.in[i] = (const float*)d_in[i];
    p.out = (float*)d_out; p.ws = (unsigned char*)d_ws;
#if MK_ONE_LAUNCH
    p.ph_lo = 0; p.ph_hi = N_STEPS;
    (void)hipMemsetAsync((char*)d_ws + WS_BAR, 0, 16384, stream);
    void* args[] = {&p};
    hipError_t e = hipLaunchCooperativeKernel((const void*)mega, dim3(grid), dim3(512), args, LDS_BYTES, stream);
    if (e != hipSuccess) fprintf(stderr, "cooperative launch failed: %s (grid %d)\n", hipGetErrorString(e), grid);
#else
    for (int st = 0; st < N_STEPS; ++st) { p.ph_lo = st; p.ph_hi = st + 1; hipLaunchKernelGGL(mega, dim3(grid), dim3(512), LDS_BYTES, stream, p); }
#endif
}
```

```cpp
#include <hip/hip_runtime.h>
#include <hip/hip_cooperative_groups.h>
#include <cstdio>
#include <cstdint>
namespace cg = cooperative_groups;

#ifndef REP_MASK
#define REP_MASK 0ull
#endif
#ifndef MK_ONE_LAUNCH
#define MK_ONE_LAUNCH 1
#endif

#define LAS __attribute__((address_space(3)))
typedef unsigned short bf16_t;
typedef short bf16x8 __attribute__((ext_vector_type(8)));
typedef float f32x4 __attribute__((ext_vector_type(4)));
typedef float f32x2 __attribute__((ext_vector_type(2)));
typedef unsigned u32x4 __attribute__((ext_vector_type(4)));
typedef unsigned u32x2 __attribute__((ext_vector_type(2)));

constexpr int T_ = 65536, D_ = 1024, SEQ_ = 8192, NB_ = 8, FF_ = 2816;
constexpr size_t MiB = (size_t)1 << 20;
constexpr size_t Mi = (size_t)1 << 20;
constexpr size_t W_RKV = 0, W_L1 = 3 * Mi, W_L2 = W_L1 + 512 * 1024, W_RWO = W_L2 + 768 * 1024, W_GIN = W_RWO + Mi, W_GOUT = W_GIN + 2 * Mi,
                 W_GS = W_GOUT + Mi, W_CAQ = W_GS + 256 * 1024, W_CAKV = W_CAQ + 2 * Mi, W_CAO = W_CAKV + 4 * Mi, W_UP = W_CAO + 2 * Mi,
                 W_DOWN = W_UP + 2 * (size_t)5632 * 1024, W_END = W_DOWN + 2 * (size_t)2816 * 1024;
static_assert(W_END * 2 <= 66 * MiB, "weights");
constexpr size_t WS_BON = 91 * MiB;
constexpr size_t WS_BAR = 95 * MiB;
constexpr size_t WS_SS = 86 * MiB;
constexpr size_t WS_MEMN = 66 * MiB, WS_KM = 70 * MiB, WS_VT = 78 * MiB, WS_BUF = 96 * MiB, SLOT = 128 * MiB;
constexpr int LDS_BYTES = 147456;
constexpr int EXTRA_OFF = 131072;

__device__ __forceinline__ unsigned cvt_pk_bf16(float lo, float hi) { unsigned r; asm volatile("v_cvt_pk_bf16_f32 %0, %1, %2" : "=v"(r) : "v"(lo), "v"(hi)); return r; }
__device__ __forceinline__ float bf_lo(unsigned u) { return __builtin_bit_cast(float, u << 16); }
__device__ __forceinline__ float bf_hi(unsigned u) { return __builtin_bit_cast(float, u & 0xffff0000u); }
__device__ __forceinline__ float sigmoidf_(float x) { return __builtin_amdgcn_rcpf(1.f + __expf(-x)); }
__device__ __forceinline__ float tanhf_(float x) { return 1.f - 2.f * __builtin_amdgcn_rcpf(1.f + __expf(2.f * x)); }
__device__ __forceinline__ float gelu_tanh(float x) { return x * sigmoidf_(1.5957691216f * (x + 0.044715f * x * x * x)); }
template <int CTRL> __device__ __forceinline__ float dpp_mov(float x) { return __builtin_bit_cast(float, __builtin_amdgcn_update_dpp(0, __builtin_bit_cast(int, x), CTRL, 0xf, 0xf, false)); }
__device__ __forceinline__ float red8(float x) { x += dpp_mov<0xB1>(x); x += dpp_mov<0x4E>(x); x += dpp_mov<0x141>(x); return x; }
__device__ __forceinline__ float red16(float x) { x += dpp_mov<0xB1>(x); x += dpp_mov<0x4E>(x); x += dpp_mov<0x141>(x); x += dpp_mov<0x140>(x); return x; }
__device__ __forceinline__ float wave_sum(float v) {
#pragma unroll
    for (int o = 32; o >= 1; o >>= 1) v += __shfl_xor(v, o, 64);
    return v;
}

__device__ __forceinline__ int lgdim() { int g = gridDim.x; asm volatile("" : "+s"(g)); return g; }
__device__ __forceinline__ int lbid() { int b = blockIdx.x; asm volatile("" : "+s"(b)); return b; }
__device__ __forceinline__ int ltid() { int t = threadIdx.x; asm volatile("" : "+v"(t)); return t; }
#define GD_ lgdim()
#define BI_ lbid()
namespace pg8 {
constexpr int BM = 256, BK = 64, HALF = 128, HTB = HALF * BK * 2, NXCD = 8, WGM = 8;
__device__ __forceinline__ int lds_byte(int r, int c) { const int st = (r >> 4) * 2 + (c >> 5), rr = r & 15, cc = c & 31, ob = rr * 64 + cc * 2; return st * 1024 + (ob ^ (((ob >> 9) & 1) << 5)); }
__device__ __forceinline__ void stage_rc(int b, int& R, int& C) { const int st = b / 1024, sb = b % 1024, swz = sb ^ (((sb >> 9) & 1) << 5); R = (st >> 1) * 16 + swz / 64; C = (st & 1) * 32 + (swz % 64) / 2; }
__device__ __forceinline__ int perm32(int rho) { const int n = rho >> 4, i = rho & 15; return 8 * (i >> 2) + 4 * n + (i & 3); }

struct Unit { int pm, pn, z, r0, rend, first; };
struct Gemm { const bf16_t* A; const bf16_t* Bt; int lda, ldb, K, nM, nN, nZ, zdiv; long zA1, zA2, zB1, zB2; int ksplit; long adelta; int ovl; int koffpn, koff; int pm0; };

struct Sched {
    int nM, nN, per, total, G, c, ovl, pm0;
    __device__ __forceinline__ void init(const Gemm& g, int G_, int c_) { nM = g.nM; nN = g.nN; per = nM * nN; total = per * g.nZ; G = G_; c = c_; ovl = g.ovl; pm0 = g.pm0; }
    __device__ __forceinline__ bool next(int i, Unit& u) const {
        const long L = (long)i * G + c; if (L >= total) return false;
        int w = (int)L; { const int q = total / NXCD, r = total % NXCD, xcd = w % NXCD, off = w / NXCD; w = (xcd < r ? xcd * (q + 1) : r * (q + 1) + (xcd - r) * q) + off; }
        u.z = w / per; w -= u.z * per;
        const int nig = WGM * nN, gid = w / nig, fm = gid * WGM, gsz = (nM - fm) < WGM ? (nM - fm) : WGM;
        u.pm = fm + ((w % nig) % gsz); u.pn = (w % nig) / gsz;
        u.pm += pm0;
        { const int b = u.pm / 33, j = u.pm - b * 33, r0o = b * SEQ_ + 254 * j - 2, eo = (b + 1) * SEQ_, ro = (r0o + BM < eo) ? r0o + BM : eo;
          const int r0 = ovl ? r0o : u.pm * BM, re = ovl ? ro : u.pm * BM + BM, fi = ovl ? (int)(j == 0) : 0; u.r0 = r0; u.rend = re; u.first = fi; }
        return true;
    }
};
__device__ __forceinline__ const char* unitA(const Gemm& g, const Unit& u) { return (const char*)(g.A + (long)(u.z / g.zdiv) * g.zA1 + (long)(u.z % g.zdiv) * g.zA2 + (long)u.r0 * g.lda + (u.pn >= g.koffpn ? g.koff : 0)); }
__device__ __forceinline__ const char* unitB(const Gemm& g, const Unit& u) { return (const char*)(g.Bt + (long)(u.z / g.zdiv) * g.zB1 + (long)(u.z % g.zdiv) * g.zB2 + (long)u.pn * BM * g.ldb + (u.pn >= g.koffpn ? g.koff : 0)); }

enum { OP_NONE = 0, OP_LORA1 = 2, OP_LORA2 = 3, OP_GELU = 4 };
struct EpiBfData { bf16_t* O; int ldc; int zdiv; long zO1, zO2; int split_cols; long split_stride; const float* p0; const float* p1; float scale; const float* ss; float* vs; LAS float* red; };
template <int OP> struct EpiBf : EpiBfData {
    static constexpr bool PERM = true, HAS_PF = false;
    __device__ __forceinline__ void operator()(const f32x4 (&acc)[2][2][4][2], const Unit& u, int wr, int wc, int fr, int fq) const {
        const int row0 = u.r0 + wr * 64 + fr; int colt = u.pn * BM; bf16_t* base = O + (long)(u.z / zdiv) * zO1 + (long)(u.z % zdiv) * zO2;
        if (split_cols) { const int t = colt / split_cols; base += (long)t * split_stride; colt -= t * split_cols; }
        const int col0 = colt + wc * 64 + 8 * fq, gcol0 = u.pn * BM + wc * 64 + 8 * fq;
        float rsv[8];
#pragma unroll
        for (int i = 0; i < 8; ++i) rsv[i] = 1024.f;
        if (OP == OP_NONE || OP == OP_GELU) { if (ss) {
#pragma unroll
            for (int i = 0; i < 8; ++i) { const f32x4 t = *(const f32x4*)(ss + (long)(row0 + (i >> 2) * HALF + (i & 3) * 16) * 4); rsv[i] = (t[0] + t[1]) + (t[2] + t[3]); } } }
#pragma unroll
        for (int ai = 0; ai < 2; ++ai)
#pragma unroll
            for (int m = 0; m < 4; ++m) {
                const int row = row0 + ai * HALF + m * 16;
                float rs = scale, t1 = 0.f, t2 = 0.f;
                if (OP == OP_NONE || OP == OP_GELU) { if (ss) rs *= rsqrtf(rsv[ai * 4 + m] * (1.f / 1024.f) + 1e-6f); }
#pragma unroll
                for (int bj = 0; bj < 2; ++bj) {
                    const int gc = gcol0 + bj * 32;
                    f32x4 q0 = {0.f, 0.f, 0.f, 0.f}, q1 = {0.f, 0.f, 0.f, 0.f};
                    if (OP == OP_LORA2) { if (gc < 1024) { q0 = *(const f32x4*)(p0 + gc); q1 = *(const f32x4*)(p0 + gc + 4); } else if (gc < 2048) { q0 = *(const f32x4*)(p1 + gc - 1024); q1 = *(const f32x4*)(p1 + gc - 1024 + 4); } }
                    bf16_t* rowp = base + (long)row * ldc + col0 + bj * 32;
                    f32x4 v0 = acc[ai][bj][m][0], v1 = acc[ai][bj][m][1];
                    if (OP == OP_NONE || OP == OP_GELU) { v0 = v0 * rs; v1 = v1 * rs; }
                    if (OP == OP_LORA1) {
                        if (gc < 64) { for (int e = 0; e < 4; ++e) { v0[e] = tanhf_(v0[e]); v1[e] = tanhf_(v1[e]); } }
                        else if (gc >= 128) { for (int e = 0; e < 4; ++e) { v0[e] = sigmoidf_(v0[e]); v1[e] = sigmoidf_(v1[e]); } }
                    }
                    if (OP == OP_LORA2) {
                        if (gc < 1024) { for (int e = 0; e < 4; ++e) { v0[e] = 0.6065306597f * sigmoidf_(v0[e] + q0[e]); v1[e] = 0.6065306597f * sigmoidf_(v1[e] + q1[e]); } }
                        else if (gc < 2048) { for (int e = 0; e < 4; ++e) { v0[e] = sigmoidf_(v0[e] + q0[e]); v1[e] = sigmoidf_(v1[e] + q1[e]); } }
                    }
                    if (OP == OP_GELU) { for (int e = 0; e < 4; ++e) { v0[e] = gelu_tanh(v0[e]); v1[e] = gelu_tanh(v1[e]); t1 += v0[e] + v1[e]; t2 += v0[e] * v0[e] + v1[e] * v1[e]; } }
                    u32x4 w; w.x = cvt_pk_bf16(v0[0], v0[1]); w.y = cvt_pk_bf16(v0[2], v0[3]); w.z = cvt_pk_bf16(v1[0], v1[1]); w.w = cvt_pk_bf16(v1[2], v1[3]);
                    *(u32x4*)rowp = w;
                }
                if (OP == OP_GELU) { if (vs && u.pn >= 4) { t1 += __shfl_xor(t1, 16, 64); t1 += __shfl_xor(t1, 32, 64); t2 += __shfl_xor(t2, 16, 64); t2 += __shfl_xor(t2, 32, 64);
                    if (fq == 0) { LAS float* d = red + ((ai * HALF + wr * 64 + m * 16 + fr) * 4 + wc) * 2; d[0] = t1; d[1] = t2; } } }
            }
        if (OP == OP_GELU) { if (vs && u.pn >= 4) {
            asm volatile("s_waitcnt lgkmcnt(0)" ::: "memory"); __builtin_amdgcn_s_barrier(); asm volatile("" ::: "memory");
            if (wc == 0 && fq == 0) {
#pragma unroll
                for (int ai = 0; ai < 2; ++ai)
#pragma unroll
                    for (int m = 0; m < 4; ++m) { const int rl = ai * HALF + wr * 64 + m * 16 + fr; const f32x4 a = *(const LAS f32x4*)(red + rl * 8), b = *(const LAS f32x4*)(red + rl * 8 + 4);
                        *(f32x2*)(vs + (long)(u.r0 + rl) * 8 + (u.pn - 4) * 2) = (f32x2){(a[0] + a[2]) + (b[0] + b[2]), (a[1] + a[3]) + (b[1] + b[3])}; }
            } } }
    }
};
struct EpiRes {
    static constexpr bool PERM = true, HAS_PF = false;
    const float* res32; bf16_t* xb; float* ss; int ldc; LAS float* red;
    __device__ __forceinline__ void operator()(const f32x4 (&acc)[2][2][4][2], const Unit& u, int wr, int wc, int fr, int fq) const {
        const int row0 = u.r0 + wr * 64 + fr, col0 = u.pn * BM + wc * 64 + 8 * fq;
#pragma unroll
        for (int ai = 0; ai < 2; ++ai)
#pragma unroll
            for (int m = 0; m < 4; ++m) {
                const int row = row0 + ai * HALF + m * 16;
                const long ro = (long)row * ldc + col0; float sq = 0.f;
#pragma unroll
                for (int bj = 0; bj < 2; ++bj) {
                    f32x4 r0, r1;
                    if (res32) { r0 = *(const f32x4*)(res32 + ro + bj * 32); r1 = *(const f32x4*)(res32 + ro + bj * 32 + 4); }
                    else { const u32x4 t = *(const u32x4*)(xb + ro + bj * 32); r0 = (f32x4){bf_lo(t.x), bf_hi(t.x), bf_lo(t.y), bf_hi(t.y)}; r1 = (f32x4){bf_lo(t.z), bf_hi(t.z), bf_lo(t.w), bf_hi(t.w)}; }
                    r0 = r0 + acc[ai][bj][m][0]; r1 = r1 + acc[ai][bj][m][1];
                    u32x4 w; w.x = cvt_pk_bf16(r0[0], r0[1]); w.y = cvt_pk_bf16(r0[2], r0[3]); w.z = cvt_pk_bf16(r1[0], r1[1]); w.w = cvt_pk_bf16(r1[2], r1[3]);
                    *(u32x4*)(xb + ro + bj * 32) = w;
                    sq += r0[0] * r0[0] + r0[1] * r0[1] + r0[2] * r0[2] + r0[3] * r0[3] + r1[0] * r1[0] + r1[1] * r1[1] + r1[2] * r1[2] + r1[3] * r1[3];
                }
                if (ss) { sq += __shfl_xor(sq, 16, 64); sq += __shfl_xor(sq, 32, 64); if (fq == 0) red[(ai * HALF + wr * 64 + m * 16 + fr) * 4 + wc] = sq; }
            }
        if (ss) {
            asm volatile("s_waitcnt lgkmcnt(0)" ::: "memory"); __builtin_amdgcn_s_barrier(); asm volatile("" ::: "memory");
            if (wc == 0 && fq == 0) {
#pragma unroll
                for (int ai = 0; ai < 2; ++ai)
#pragma unroll
                    for (int m = 0; m < 4; ++m) { const int rl = ai * HALF + wr * 64 + m * 16 + fr; const f32x4 r4 = *(const LAS f32x4*)(red + rl * 4);
                        ss[(long)(u.r0 + rl) * 4 + u.pn] = (r4[0] + r4[1]) + (r4[2] + r4[3]); }
            }
        }
    }
};
struct EpiConv {
    static constexpr bool PERM = true, HAS_PF = true;
    __device__ __forceinline__ void prefetch(const Unit& u, LAS unsigned char* lds, int wid, int lane) const {
        if (wid < 4) __builtin_amdgcn_global_load_lds((const unsigned*)(ss + (long)(u.r0 + wid * 64 + lane) * 4), (LAS unsigned*)(lds + EXTRA_OFF + 8192 + wid * 1024), 16, 0, 0);
    }
    bf16_t* H; const float* cw; const float* cb; const float* ss; LAS float* ex;
    __device__ __forceinline__ void operator()(f32x4 (&acc)[2][2][4][2], const Unit& u, int wr, int wc, int fr, int fq) const {
        const int rowb = u.r0 + wr * 64 + fr, colg = u.pn * HALF + wc * 32 + 8 * fq;
#pragma unroll
        for (int ai = 0; ai < 2; ++ai)
#pragma unroll
            for (int m = 0; m < 4; ++m) {
                const f32x4 st4 = *(const LAS f32x4*)(ex + 2048 + (wr * 64 + fr + ai * HALF + m * 16) * 4);   float rs = rsqrtf(((st4[0] + st4[1]) + (st4[2] + st4[3])) * (1.f / 1024.f) + 1e-6f);
                const bool zg = (u.first && ai == 0 && m == 0 && wr == 0 && fr < 2);
                acc[ai][1][m][0] = acc[ai][1][m][0] * rs; acc[ai][1][m][1] = acc[ai][1][m][1] * rs;
                if (zg) { acc[ai][0][m][0] = (f32x4){0.f, 0.f, 0.f, 0.f}; acc[ai][0][m][1] = (f32x4){0.f, 0.f, 0.f, 0.f}; }
                else { acc[ai][0][m][0] = acc[ai][0][m][0] * rs; acc[ai][0][m][1] = acc[ai][0][m][1] * rs; }
            }
        if (fr >= 14) {
#pragma unroll
            for (int ai = 0; ai < 2; ++ai) { LAS float* d = ex + ((((ai * 2 + wr) * 4 + wc) * 2 + (fr - 14)) * 32 + fq * 8); *(LAS f32x4*)d = acc[ai][0][3][0]; *(LAS f32x4*)(d + 4) = acc[ai][0][3][1]; }
        }
        f32x4 w0[2], w1[2], w2[2], bb[2];
#pragma unroll
        for (int n = 0; n < 2; ++n) { w0[n] = *(const f32x4*)(cw + colg + 4 * n); w1[n] = *(const f32x4*)(cw + FF_ + colg + 4 * n); w2[n] = *(const f32x4*)(cw + 2 * FF_ + colg + 4 * n); bb[n] = *(const f32x4*)(cb + colg + 4 * n); }
        asm volatile("s_waitcnt lgkmcnt(0)" ::: "memory"); __builtin_amdgcn_s_barrier(); asm volatile("" ::: "memory");
#pragma unroll
        for (int ai = 0; ai < 2; ++ai)
#pragma unroll
            for (int m = 0; m < 4; ++m) {
                const int row = rowb + ai * HALF + m * 16;
                u32x4 w;
                f32x4 P1[2] = {{0.f, 0.f, 0.f, 0.f}, {0.f, 0.f, 0.f, 0.f}}, P2[2] = {{0.f, 0.f, 0.f, 0.f}, {0.f, 0.f, 0.f, 0.f}};
                if (m == 0) { const int pblk = ai * 2 + wr - 1;
                    if (pblk >= 0) { const LAS float* s = ex + ((pblk * 4 + wc) * 2) * 32 + fq * 8; P2[0] = *(const LAS f32x4*)s; P2[1] = *(const LAS f32x4*)(s + 4); P1[0] = *(const LAS f32x4*)(s + 32); P1[1] = *(const LAS f32x4*)(s + 36); } }
#pragma unroll
                for (int n = 0; n < 2; ++n) {
                    float hh[4];
#pragma unroll
                    for (int i = 0; i < 4; ++i) {
                        const float g0 = acc[ai][0][m][n][i];
                        float o1, o2;
                        if (m > 0) { const float pv = acc[ai][0][m > 0 ? m - 1 : 0][n][i]; o1 = dpp_mov<0x121>(pv); o2 = dpp_mov<0x122>(pv); }
                        else { o1 = P1[n][i]; o2 = (fr == 0) ? P2[n][i] : P1[n][i]; }
                        const float up1 = __builtin_bit_cast(float, __builtin_amdgcn_update_dpp(__builtin_bit_cast(int, o1), __builtin_bit_cast(int, g0), 0x111, 0xf, 0xf, false));
                        const float up2 = __builtin_bit_cast(float, __builtin_amdgcn_update_dpp(__builtin_bit_cast(int, o2), __builtin_bit_cast(int, g0), 0x112, 0xf, 0xf, false));
                        const float cv = up2 * w0[n][i] + up1 * w1[n][i] + g0 * w2[n][i] + bb[n][i];
                        hh[i] = cv * sigmoidf_(cv) * acc[ai][1][m][n][i];
                    }
                    if (n == 0) { w.x = cvt_pk_bf16(hh[0], hh[1]); w.y = cvt_pk_bf16(hh[2], hh[3]); } else { w.z = cvt_pk_bf16(hh[0], hh[1]); w.w = cvt_pk_bf16(hh[2], hh[3]); }
                }
                if (row >= u.r0 + 2 && row < u.rend) *(u32x4*)(H + (long)row * FF_ + colg) = w;
            }
    }
};
struct EpiSoftmax {
    static constexpr bool PERM = true, HAS_PF = false;
    bf16_t* P; LAS float* red;
    __device__ __forceinline__ void operator()(f32x4 (&acc)[2][2][4][2], const Unit& u, int wr, int wc, int fr, int fq) const {
        float mx[2][4];
#pragma unroll
        for (int ai = 0; ai < 2; ++ai)
#pragma unroll
            for (int m = 0; m < 4; ++m) {
                float v = -3.0e38f;
#pragma unroll
                for (int bj = 0; bj < 2; ++bj)
#pragma unroll
                    for (int n = 0; n < 2; ++n)
#pragma unroll
                        for (int e = 0; e < 4; ++e) v = fmaxf(v, acc[ai][bj][m][n][e]);
                v = fmaxf(v, __shfl_xor(v, 16, 64)); v = fmaxf(v, __shfl_xor(v, 32, 64));
                if (fq == 0) red[(ai * HALF + wr * 64 + m * 16 + fr) * 4 + wc] = v;
                mx[ai][m] = v;
            }
        asm volatile("s_waitcnt lgkmcnt(0)" ::: "memory"); __builtin_amdgcn_s_barrier(); asm volatile("" ::: "memory");
#pragma unroll
        for (int ai = 0; ai < 2; ++ai)
#pragma unroll
            for (int m = 0; m < 4; ++m) {
                const f32x4 r4 = *(const LAS f32x4*)(red + (ai * HALF + wr * 64 + m * 16 + fr) * 4);
                const float M = fmaxf(fmaxf(r4[0], r4[1]), fmaxf(r4[2], r4[3]));
                float s = 0.f;
#pragma unroll
                for (int bj = 0; bj < 2; ++bj)
#pragma unroll
                    for (int n = 0; n < 2; ++n)
#pragma unroll
                        for (int e = 0; e < 4; ++e) { const float p = __expf(acc[ai][bj][m][n][e] - M); acc[ai][bj][m][n][e] = p; s += p; }
                s += __shfl_xor(s, 16, 64); s += __shfl_xor(s, 32, 64);
                if (fq == 0) red[1024 + (ai * HALF + wr * 64 + m * 16 + fr) * 4 + wc] = s;
            }
        asm volatile("s_waitcnt lgkmcnt(0)" ::: "memory"); __builtin_amdgcn_s_barrier(); asm volatile("" ::: "memory");
        const int b = u.z >> 2, h = u.z & 3;
        bf16_t* base = P + ((long)b * SEQ_ + u.r0 + wr * 64 + fr) * D_ + h * 256 + wc * 64 + 8 * fq;
#pragma unroll
        for (int ai = 0; ai < 2; ++ai)
#pragma unroll
            for (int m = 0; m < 4; ++m) {
                const f32x4 r4 = *(const LAS f32x4*)(red + 1024 + (ai * HALF + wr * 64 + m * 16 + fr) * 4);
                const float inv = 1.f / (r4[0] + r4[1] + r4[2] + r4[3]);
#pragma unroll
                for (int bj = 0; bj < 2; ++bj) {
                    const f32x4 v0 = acc[ai][bj][m][0] * inv, v1 = acc[ai][bj][m][1] * inv;
                    u32x4 w; w.x = cvt_pk_bf16(v0[0], v0[1]); w.y = cvt_pk_bf16(v0[2], v0[3]); w.z = cvt_pk_bf16(v1[0], v1[1]); w.w = cvt_pk_bf16(v1[2], v1[3]);
                    *(u32x4*)(base + (long)(ai * HALF + m * 16) * D_ + bj * 32) = w;
                }
            }
    }
};

template <class Epi> struct MakeEpi;
template <class Epi, bool SPLITA, class PT>
__device__ __forceinline__ void gemm_phase(LAS unsigned char* lds, const Gemm g, const PT& P, int step, int Gs = 0, int bi = 0) {
    const int tid = ltid(), wid = __builtin_amdgcn_readfirstlane(tid >> 6), lane = tid & 63, wr = wid >> 2, wc = wid & 3, fr = lane & 15, fq = lane >> 4;
    const int K = g.K, nt = K / BK;
    Sched S; if (Gs > 0) S.init(g, Gs, bi); else S.init(g, GD_, BI_);
    unsigned voffA[2], voffB[2];
#pragma unroll
    for (int i = 0; i < 2; ++i) { int R, C; stage_rc(tid * 16 + i * 8192, R, C); const int Rb = Epi::PERM ? (64 * (R >> 5) + perm32(R & 31)) : R;
        voffA[i] = (unsigned)(R * g.lda + C) * 2u; voffB[i] = (unsigned)(Rb * g.ldb + C) * 2u; }
    const size_t kstep = (size_t)(BK * 2);
    const size_t hstepA = (size_t)HALF * g.lda * 2, hstepB = (size_t)(Epi::PERM ? 32 : HALF) * g.ldb * 2;
    const unsigned ldsw = (unsigned)wid * 1024u;
    const int aoff = lds_byte(wr * 64 + fr, fq * 8), boff = lds_byte(wc * 32 + fr, fq * 8);
#define PG8_SA(b, h) (((b) * 2 + (h)) * HTB)
#define PG8_SB(b, h) ((4 + (b) * 2 + (h)) * HTB)
#define PG8_STAGE(bufoff, gbase, voff) do { _Pragma("unroll") for (int _i = 0; _i < 2; ++_i) \
        __builtin_amdgcn_global_load_lds((const unsigned*)((const char*)(gbase) + (voff)[_i]), (LAS unsigned*)(lds + (bufoff) + ldsw + _i * 8192), 16, 0, 0); } while (0)
#define PG8_LDA(dst, b, h) do { _Pragma("unroll") for (int m = 0; m < 4; ++m) _Pragma("unroll") for (int k = 0; k < 2; ++k) dst[m][k] = *(const LAS bf16x8*)(lds + PG8_SA(b, h) + aoff + m * 2048 + k * 1024); } while (0)
#define PG8_LDB(dst, b, h) do { _Pragma("unroll") for (int n = 0; n < 2; ++n) _Pragma("unroll") for (int k = 0; k < 2; ++k) dst[n][k] = *(const LAS bf16x8*)(lds + PG8_SB(b, h) + boff + n * 2048 + k * 1024); } while (0)
#define PG8_MMA(ai, bj, At, Bt) do { __builtin_amdgcn_s_setprio(1); _Pragma("unroll") for (int m = 0; m < 4; ++m) _Pragma("unroll") for (int n = 0; n < 2; ++n) _Pragma("unroll") for (int k = 0; k < 2; ++k) \
        acc[ai][bj][m][n] = __builtin_amdgcn_mfma_f32_16x16x32_bf16(Bt[n][k], At[m][k], acc[ai][bj][m][n], 0, 0, 0); __builtin_amdgcn_s_setprio(0); } while (0)
#define PG8_WAIT_V(n) asm volatile("s_waitcnt vmcnt(" #n ")" ::: "memory")
#define PG8_WAIT_L(n) asm volatile("s_waitcnt lgkmcnt(" #n ")" ::: "memory")
#define PG8_BAR __builtin_amdgcn_s_barrier()
#define PG8_SCHED __builtin_amdgcn_sched_barrier(0)
#define PG8_AK(base, t) ((base) + (size_t)(t) * kstep + ((SPLITA && (t) >= g.ksplit) ? g.adelta : 0l))
    Unit cur, nxt; int ui = 0;
    if (!S.next(0, cur)) return;
    f32x4 acc[2][2][4][2];
#pragma unroll
    for (int a = 0; a < 2; ++a)
#pragma unroll
        for (int b = 0; b < 2; ++b)
#pragma unroll
            for (int m = 0; m < 4; ++m)
#pragma unroll
                for (int n = 0; n < 2; ++n) acc[a][b][m][n] = (f32x4){0.f, 0.f, 0.f, 0.f};
    bf16x8 At[4][2], B0[2][2], B1[2][2];
    const char* cA = unitA(g, cur); const char* cB = unitB(g, cur);
    PG8_STAGE(PG8_SB(0, 0), cB, voffB); PG8_STAGE(PG8_SB(0, 1), cB + hstepB, voffB); PG8_STAGE(PG8_SA(0, 0), cA, voffA); PG8_STAGE(PG8_SA(0, 1), cA + hstepA, voffA);
    if (wr == 1) PG8_BAR;
    PG8_WAIT_V(2); PG8_BAR;
    PG8_STAGE(PG8_SB(1, 0), cB + kstep, voffB); PG8_STAGE(PG8_SA(1, 0), cA + kstep, voffA); PG8_STAGE(PG8_SB(1, 1), cB + hstepB + kstep, voffB);
    PG8_WAIT_V(6); PG8_BAR;
    for (;;) {
        const bool has_next = S.next(ui + 1, nxt);
        const char* nA = has_next ? unitA(g, nxt) : cA; const char* nB = has_next ? unitB(g, nxt) : cB;
        if constexpr (Epi::HAS_PF) { int st3 = step; asm volatile("" : "+s"(st3)); const Epi Ep = MakeEpi<Epi>::make(P, st3, lds); Ep.prefetch(cur, lds, wid, lane); }
        for (int t = 0; t < nt; t += 2) {
            const bool last = (t == nt - 2);
            const char* a1 = PG8_AK(cA, t + 1);
            const char* a2 = last ? nA : PG8_AK(cA, t + 2); const char* b2 = last ? nB : cB + (size_t)(t + 2) * kstep;
            const char* a3 = last ? nA + kstep : PG8_AK(cA, t + 3); const char* b3 = b2 + kstep;
            PG8_LDB(B0, 0, 0); PG8_LDB(B1, 0, 1); PG8_SCHED; PG8_LDA(At, 0, 0); PG8_STAGE(PG8_SA(1, 1), a1 + hstepA, voffA);
            PG8_WAIT_V(8); PG8_WAIT_L(0); PG8_BAR; PG8_MMA(0, 0, At, B0); PG8_MMA(0, 1, At, B1); PG8_BAR; PG8_SCHED;
            PG8_LDA(At, 0, 1); PG8_STAGE(PG8_SB(0, 0), b2, voffB); PG8_STAGE(PG8_SB(0, 1), b2 + hstepB, voffB); PG8_STAGE(PG8_SA(0, 0), a2, voffA);
            PG8_WAIT_V(8); PG8_WAIT_L(0); PG8_BAR; PG8_MMA(1, 0, At, B0); PG8_MMA(1, 1, At, B1); PG8_BAR; PG8_SCHED;
            PG8_LDB(B0, 1, 0); PG8_LDB(B1, 1, 1); PG8_SCHED; PG8_LDA(At, 1, 0); PG8_STAGE(PG8_SA(0, 1), a2 + hstepA, voffA);
            PG8_WAIT_V(8); PG8_WAIT_L(0); PG8_BAR; PG8_MMA(0, 0, At, B0); PG8_MMA(0, 1, At, B1); PG8_BAR; PG8_SCHED;
            PG8_LDA(At, 1, 1); PG8_STAGE(PG8_SB(1, 0), b3, voffB); PG8_STAGE(PG8_SB(1, 1), b3 + hstepB, voffB); PG8_STAGE(PG8_SA(1, 0), a3, voffA);
            PG8_WAIT_V(8); PG8_WAIT_L(0); PG8_BAR; PG8_MMA(1, 0, At, B0); PG8_MMA(1, 1, At, B1); PG8_BAR; PG8_SCHED;
        }
        if (wr == 0) PG8_BAR;
        { int st2 = step; asm volatile("" : "+s"(st2)); const Epi E = MakeEpi<Epi>::make(P, st2, lds); E(acc, cur, wr, wc, fr, fq); }
        if (!has_next) break;
#pragma unroll
        for (int a = 0; a < 2; ++a)
#pragma unroll
            for (int b = 0; b < 2; ++b)
#pragma unroll
                for (int m = 0; m < 4; ++m)
#pragma unroll
                    for (int n = 0; n < 2; ++n) acc[a][b][m][n] = (f32x4){0.f, 0.f, 0.f, 0.f};
        cur = nxt; cA = nA; cB = nB; ++ui;
        if (wr == 1) PG8_BAR;
    }
    PG8_WAIT_V(0);
    PG8_BAR;
#undef PG8_SA
#undef PG8_SB
#undef PG8_STAGE
#undef PG8_LDA
#undef PG8_LDB
#undef PG8_MMA
#undef PG8_WAIT_V
#undef PG8_WAIT_L
#undef PG8_BAR
#undef PG8_SCHED
#undef PG8_AK
}
}

struct Params { const float* in[36]; float* out; unsigned char* ws; int ph_lo, ph_hi; };
enum { I_X = 0, I_MEM, I_NMIX, I_NMEM, I_NFFN, I_NFIN, I_MEMNORM, I_MU, I_WRKV, I_W0, I_W1, I_W2, I_A0, I_A1, I_A2, I_G1, I_G2, I_KK, I_KA, I_RK, I_LNXG, I_LNXB, I_RWO,
       I_GIN, I_GLNG, I_GLNB, I_GWS, I_GBS, I_GOUT, I_CAQ, I_CAKV, I_CAO, I_UP, I_CONVW, I_CONVB, I_DOWN };

__device__ __forceinline__ bf16_t* wsW(const Params& p, size_t eoff) { return (bf16_t*)p.ws + eoff; }
__device__ __forceinline__ bf16_t* slot(const Params& p, int i) { return (bf16_t*)(p.ws + WS_BUF + (size_t)i * SLOT); }

__device__ __forceinline__ void tr_job(const float* src, int K, int N, bf16_t* dst, int ldt, int& gbase, LAS float* tile, const float* rowscale = nullptr, int upmap = 0, int bi = -1, int Gs = 0) {
    const int tid = ltid(), ntn = N / 64, nt = (K / 64) * ntn, G = (bi >= 0) ? Gs : GD_; if (bi < 0) bi = BI_;
    int g = gbase + ((bi - gbase) % G + G) % G;
    for (; g < gbase + nt; g += G) {
        const int ti = g - gbase, k0 = (ti / ntn) * 64, n0 = (ti % ntn) * 64;
        __syncthreads();
        { const int kk = tid >> 4, n4 = (tid & 15) * 4;
#pragma unroll
          for (int h = 0; h < 2; ++h) { f32x4 v = *(const f32x4*)(src + (size_t)(k0 + kk + h * 32) * N + n0 + n4); if (rowscale) v = v * rowscale[k0 + kk + h * 32];
              LAS float* d = tile + (kk + h * 32) * 65 + n4; d[0] = v[0]; d[1] = v[1]; d[2] = v[2]; d[3] = v[3]; } }
        __syncthreads();
        { const int nn = tid >> 3, k8 = (tid & 7) * 8; float v[8];
#pragma unroll
          for (int j = 0; j < 8; ++j) v[j] = tile[(k8 + j) * 65 + nn];
          u32x4 w; w.x = cvt_pk_bf16(v[0], v[1]); w.y = cvt_pk_bf16(v[2], v[3]); w.z = cvt_pk_bf16(v[4], v[5]); w.w = cvt_pk_bf16(v[6], v[7]);
          int dr = n0 + nn; if (upmap) { const int nv = (n0 < FF_) ? n0 : n0 - FF_; dr = 256 * (nv / 128) + 2 * (nv % 128) + ((n0 < FF_) ? 0 : 32) + nn + ((nn >= 32) ? 32 : 0); }
          *(u32x4*)(dst + (size_t)dr * ldt + k0 + k8) = w; }
    }
    gbase += nt;
}
__device__ __forceinline__ unsigned short bf1(float v) { return (unsigned short)(cvt_pk_bf16(v, 0.f) & 0xffffu); }

__device__ __forceinline__ void phase_convert_late(const Params& p, LAS unsigned char* lds, int bi, int Gs) {
    LAS float* tile = (LAS float*)lds;
    int gb = 0;
    tr_job(p.in[I_GIN], 1024, 2048, wsW(p, W_GIN), 1024, gb, tile, p.in[I_NMIX] + 1024, 0, bi, Gs);
    tr_job(p.in[I_GOUT], 1024, 1024, wsW(p, W_GOUT), 1024, gb, tile, nullptr, 0, bi, Gs);
    for (int l = 0; l < 2; ++l) {
        tr_job(p.in[I_CAQ] + (size_t)l * Mi, 1024, 1024, wsW(p, W_CAQ + l * Mi), 1024, gb, tile, p.in[I_NMEM] + l * 1024, 0, bi, Gs);
        tr_job(p.in[I_CAO] + (size_t)l * Mi, 1024, 1024, wsW(p, W_CAO + l * Mi), 1024, gb, tile, nullptr, 0, bi, Gs);
        tr_job(p.in[I_UP] + (size_t)l * 5632 * 1024, 1024, 5632, wsW(p, W_UP + (size_t)l * 5632 * 1024), 1024, gb, tile, p.in[I_NFFN] + l * 1024, 1, bi, Gs);
        tr_job(p.in[I_DOWN] + (size_t)l * 2816 * 1024, 2816, 1024, wsW(p, W_DOWN + (size_t)l * 2816 * 1024), 2816, gb, tile, nullptr, 0, bi, Gs);
    }
    const int tid0 = ltid();
    for (int idx = bi * 512 + tid0; idx < 16 * 128 * 128; idx += Gs * 512) {
        const int t = (idx >> 7) & 127, s = idx & 127;
        wsW(p, W_GS)[idx] = bf1(s <= t ? p.in[I_GWS][idx] : 0.f);
    }
}
__device__ __forceinline__ void phase_prologue(const Params& p, LAS unsigned char* lds) {
    LAS float* tile = (LAS float*)lds;
    int gb = 0;
    for (int j = 0; j < 3; ++j) tr_job(p.in[I_WRKV] + (size_t)j * Mi, 1024, 1024, wsW(p, W_RKV + j * Mi), 1024, gb, tile);
    tr_job(p.in[I_RWO], 1024, 1024, wsW(p, W_RWO), 1024, gb, tile);
    for (int l = 0; l < 2; ++l) tr_job(p.in[I_CAKV] + (size_t)l * 2 * Mi, 1024, 2048, wsW(p, W_CAKV + l * 2 * Mi), 1024, gb, tile);
    const int tid0 = ltid(); const int gtid = BI_ * 512 + tid0, gth = GD_ * 512;
    for (int idx = gtid; idx < 256 * 2048; idx += gth) {
        const int n = idx >> 11, k = idx & 2047, kk = k & 1023;
        const float* src; int nn, Ns, mi;
        if (n < 64) { src = p.in[I_W1]; nn = n; Ns = 64; mi = 1; } else if (n < 128) { src = p.in[I_A1]; nn = n - 64; Ns = 64; mi = 4; } else { src = p.in[I_G1]; nn = n - 128; Ns = 128; mi = 5; }
        float v = src[kk * Ns + nn]; if (k >= 1024) v *= (p.in[I_MU][mi * 1024 + kk] - p.in[I_MU][kk]);
        wsW(p, W_L1)[idx] = bf1(v);
    }
    for (int idx = gtid; idx < 3072 * 256; idx += gth) {
        const int n = idx >> 8, k = idx & 255; float v = 0.f;
        if (n < 1024) { if (k < 64) v = p.in[I_W2][k * 1024 + n]; }
        else if (n < 2048) { if (k >= 64 && k < 128) v = p.in[I_A2][(k - 64) * 1024 + n - 1024]; }
        else { if (k >= 128) v = p.in[I_G2][(k - 128) * 1024 + n - 2048]; }
        wsW(p, W_L2)[idx] = bf1(v);
    }
    const int wave = tid0 >> 6, lane = tid0 & 63;
    for (int row = BI_ * 8 + wave; row < 2048; row += GD_ * 8) {
        const float* xr = p.in[I_MEM] + (size_t)row * 1024; f32x4 v[4]; float ss = 0.f;
#pragma unroll
        for (int i = 0; i < 4; ++i) { v[i] = *(const f32x4*)(xr + i * 256 + lane * 4); ss += v[i][0] * v[i][0] + v[i][1] * v[i][1] + v[i][2] * v[i][2] + v[i][3] * v[i][3]; }
        ss = wave_sum(ss); const float rs = rsqrtf(ss * (1.f / 1024.f) + 1e-6f);
        bf16_t* o = (bf16_t*)(p.ws + WS_MEMN) + (size_t)row * 1024;
#pragma unroll
        for (int i = 0; i < 4; ++i) { const f32x4 g = *(const f32x4*)(p.in[I_MEMNORM] + i * 256 + lane * 4);
            u32x2 w; w.x = cvt_pk_bf16(v[i][0] * rs * g[0], v[i][1] * rs * g[1]); w.y = cvt_pk_bf16(v[i][2] * rs * g[2], v[i][3] * rs * g[3]);
            *(u32x2*)(o + i * 256 + lane * 4) = w; }
    }
}

__device__ __forceinline__ void phase_rms(const float* x, const float* gain, bf16_t* out) {
    const int tid0 = ltid(); const int wave = tid0 >> 6, lane = tid0 & 63;
    f32x4 g[4];
#pragma unroll
    for (int i = 0; i < 4; ++i) g[i] = *(const f32x4*)(gain + i * 256 + lane * 4);
    for (int row = BI_ * 8 + wave; row < T_; row += GD_ * 8) {
        const float* xr = x + (size_t)row * 1024; f32x4 v[4]; float ss = 0.f;
#pragma unroll
        for (int i = 0; i < 4; ++i) { v[i] = *(const f32x4*)(xr + i * 256 + lane * 4); ss += v[i][0] * v[i][0] + v[i][1] * v[i][1] + v[i][2] * v[i][2] + v[i][3] * v[i][3]; }
        ss = wave_sum(ss); const float rs = rsqrtf(ss * (1.f / 1024.f) + 1e-6f);
        bf16_t* o = out + (size_t)row * 1024;
#pragma unroll
        for (int i = 0; i < 4; ++i) { u32x2 w; w.x = cvt_pk_bf16(v[i][0] * rs * g[i][0], v[i][1] * rs * g[i][1]); w.y = cvt_pk_bf16(v[i][2] * rs * g[i][2], v[i][3] * rs * g[i][3]);
            *(u32x2*)(o + i * 256 + lane * 4) = w; }
    }
}
__device__ __forceinline__ void phase_final(const bf16_t* xb, float* out, const float* gain) {
    const int tid0 = ltid(); const int wave = tid0 >> 6, lane = tid0 & 63;
    f32x4 g[4];
#pragma unroll
    for (int i = 0; i < 4; ++i) g[i] = *(const f32x4*)(gain + i * 256 + lane * 4);
    for (int row = (BI_ * 8 + wave) * 2; row < T_; row += GD_ * 16) {
        u32x2 t[2][4];
#pragma unroll
        for (int q = 0; q < 2; ++q)
#pragma unroll
            for (int i = 0; i < 4; ++i) t[q][i] = *(const u32x2*)(xb + (size_t)(row + q) * 1024 + i * 256 + lane * 4);
#pragma unroll
        for (int q = 0; q < 2; ++q) {
            f32x4 v[4]; float ss = 0.f;
#pragma unroll
            for (int i = 0; i < 4; ++i) { v[i] = (f32x4){bf_lo(t[q][i].x), bf_hi(t[q][i].x), bf_lo(t[q][i].y), bf_hi(t[q][i].y)}; ss += v[i][0] * v[i][0] + v[i][1] * v[i][1] + v[i][2] * v[i][2] + v[i][3] * v[i][3]; }
            ss = wave_sum(ss); const float rs = rsqrtf(ss * (1.f / 1024.f) + 1e-6f);
#pragma unroll
            for (int i = 0; i < 4; ++i) *(f32x4*)(out + (size_t)(row + q) * 1024 + i * 256 + lane * 4) = v[i] * rs * g[i];
        }
    }
}
__device__ __forceinline__ void phase_r0(const Params& p) {
    const int tid0 = ltid(); const int wave = tid0 >> 6, lane = tid0 & 63;
    const float* x = p.in[I_X]; const float* gain = p.in[I_NMIX]; const float* mu = p.in[I_MU];
    bf16_t* DX = slot(p, 1); bf16_t* XR = slot(p, 2); bf16_t* XK = slot(p, 3); bf16_t* XV = slot(p, 4);
    f32x4 gn[4], mr[4], mk[4], mv[4];
#pragma unroll
    for (int i = 0; i < 4; ++i) { const int c = i * 256 + lane * 4; gn[i] = *(const f32x4*)(gain + c); mr[i] = *(const f32x4*)(mu + c); mk[i] = *(const f32x4*)(mu + 2 * 1024 + c); mv[i] = *(const f32x4*)(mu + 3 * 1024 + c); }
    for (int task = BI_ * 8 + wave; task < T_ / 32; task += GD_ * 8) {
        const int t0 = task * 32;
f32x4 hp[4];
        if ((t0 & (SEQ_ - 1)) == 0) { for (int i = 0; i < 4; ++i) hp[i] = (f32x4){0.f, 0.f, 0.f, 0.f}; }
        else {
            const float* xr = x + (size_t)(t0 - 1) * 1024; float ss = 0.f;
#pragma unroll
            for (int i = 0; i < 4; ++i) { hp[i] = *(const f32x4*)(xr + i * 256 + lane * 4); ss += hp[i][0] * hp[i][0] + hp[i][1] * hp[i][1] + hp[i][2] * hp[i][2] + hp[i][3] * hp[i][3]; }
            ss = wave_sum(ss); const float rs = rsqrtf(ss * (1.f / 1024.f) + 1e-6f);
#pragma unroll
            for (int i = 0; i < 4; ++i) hp[i] = hp[i] * rs * gn[i];
        }
        f32x4 vn[4];
#pragma unroll
        for (int i = 0; i < 4; ++i) vn[i] = *(const f32x4*)(x + (size_t)t0 * 1024 + i * 256 + lane * 4);
        for (int r = 0; r < 32; ++r) {
            const size_t ro = (size_t)(t0 + r) * 1024; f32x4 v[4]; float ss = 0.f;
#pragma unroll
            for (int i = 0; i < 4; ++i) { v[i] = vn[i]; ss += v[i][0] * v[i][0] + v[i][1] * v[i][1] + v[i][2] * v[i][2] + v[i][3] * v[i][3]; }
            if (r + 1 < 32) {
#pragma unroll
                for (int i = 0; i < 4; ++i) vn[i] = *(const f32x4*)(x + ro + 1024 + i * 256 + lane * 4);
            }
            ss = wave_sum(ss); const float rs = rsqrtf(ss * (1.f / 1024.f) + 1e-6f);
#pragma unroll
            for (int i = 0; i < 4; ++i) {
                const int c = i * 256 + lane * 4;
                const f32x4 h = v[i] * rs * gn[i];
                const f32x4 dx = hp[i] - h; hp[i] = h;
                const f32x4 a = h + dx * mr[i], b = h + dx * mk[i], d = h + dx * mv[i];
                u32x2 w;
                w.x = cvt_pk_bf16(dx[0], dx[1]); w.y = cvt_pk_bf16(dx[2], dx[3]); *(u32x2*)(DX + ro + c) = w;
                w.x = cvt_pk_bf16(a[0], a[1]); w.y = cvt_pk_bf16(a[2], a[3]); *(u32x2*)(XR + ro + c) = w;
                w.x = cvt_pk_bf16(b[0], b[1]); w.y = cvt_pk_bf16(b[2], b[3]); *(u32x2*)(XK + ro + c) = w;
                w.x = cvt_pk_bf16(d[0], d[1]); w.y = cvt_pk_bf16(d[2], d[3]); *(u32x2*)(XV + ro + c) = w;
            }
        }
    }
}

typedef short s16x4 __attribute__((ext_vector_type(4)));
typedef __bf16 bf16x2_t __attribute__((ext_vector_type(2)));
__device__ __forceinline__ unsigned cvt2(float lo, float hi) { f32x2 v = {lo, hi}; bf16x2_t b = __builtin_convertvector(v, bf16x2_t); return __builtin_bit_cast(unsigned, b); }
__device__ __forceinline__ s16x4 cvt4(f32x4 x) { u32x2 q = {cvt2(x[0], x[1]), cvt2(x[2], x[3])}; return __builtin_bit_cast(s16x4, q); }
__device__ __forceinline__ unsigned short bfs(float x) { return (unsigned short)(cvt2(x, 0.f) & 0xffffu); }
__device__ __forceinline__ float bfl(unsigned short x) { return __builtin_bit_cast(float, (unsigned)x << 16); }
#define MFMA16(a, b, c) __builtin_amdgcn_mfma_f32_16x16x16bf16_1k((a), (b), (c), 0, 0, 0)
#define MFMA32(a, b, c) __builtin_amdgcn_mfma_f32_16x16x32_bf16((a), (b), (c), 0, 0, 0)
constexpr int RS_ = 144, SM_ = 40;
constexpr int PK_QH = 0, PK_RT = 2304, PK_NH = 4608, PK_MBN = 5248, PK_MK = 5888, PK_BPN = 6528, PK_KP = 8672, PK_VT = 10816, PK_DC = 12960, PK_BYTES = 13312;
constexpr int SCR_QM = 0, SCR_BM = 2304, SCR_KM = 4608, SCR_QT = 6912, SCR_BYTES = 9216, SCAN_SCR_OFF = 8 * PK_BYTES;
static_assert(SCAN_SCR_OFF + 4 * SCR_BYTES + 768 <= LDS_BYTES - 64, "scan LDS");

struct ScanRaw { u32x4 r[2], e[2], k[2], v[2], a[2]; };
__device__ __forceinline__ void scan_load(ScanRaw& x, const bf16_t* Rb, const bf16_t* Wb, const bf16_t* Kb, const bf16_t* Vb, const bf16_t* Ab, size_t base, int lane) {
    const size_t o = base + (size_t)(lane >> 2) * 1024 + (lane & 3) * 16;
#pragma unroll
    for (int q = 0; q < 2; ++q) { x.r[q] = *(const u32x4*)(Rb + o + 8 * q); x.e[q] = *(const u32x4*)(Wb + o + 8 * q); x.k[q] = *(const u32x4*)(Kb + o + 8 * q); x.v[q] = *(const u32x4*)(Vb + o + 8 * q); x.a[q] = *(const u32x4*)(Ab + o + 8 * q); }
}
__device__ __forceinline__ void unpack16(const u32x4 (&u)[2], float (&f)[16]) {
#pragma unroll
    for (int q = 0; q < 2; ++q) { f[8 * q] = bf_lo(u[q].x); f[8 * q + 1] = bf_hi(u[q].x); f[8 * q + 2] = bf_lo(u[q].y); f[8 * q + 3] = bf_hi(u[q].y); f[8 * q + 4] = bf_lo(u[q].z); f[8 * q + 5] = bf_hi(u[q].z); f[8 * q + 6] = bf_lo(u[q].w); f[8 * q + 7] = bf_hi(u[q].w); }
}
__device__ __forceinline__ void st_row16(LAS unsigned char* dst, const float (&t)[16]) {
    u32x4 w0, w1; w0.x = cvt2(t[0], t[1]); w0.y = cvt2(t[2], t[3]); w0.z = cvt2(t[4], t[5]); w0.w = cvt2(t[6], t[7]); w1.x = cvt2(t[8], t[9]); w1.y = cvt2(t[10], t[11]); w1.z = cvt2(t[12], t[13]); w1.w = cvt2(t[14], t[15]);
    *(LAS u32x4*)dst = w0; *(LAS u32x4*)(dst + 16) = w1;
}
__device__ __forceinline__ f32x4 unpk4(const u32x4 (&u)[2], int q) { const unsigned lo = (q & 1) ? u[q >> 1].z : u[q >> 1].x, hi = (q & 1) ? u[q >> 1].w : u[q >> 1].y; return (f32x4){bf_lo(lo), bf_hi(lo), bf_lo(hi), bf_hi(hi)}; }
__device__ __forceinline__ void scan_produce(const ScanRaw& x, LAS unsigned char* pkg, LAS unsigned char* scr, int lane, const LAS float* kkg, const LAS float* kag, const LAS float* rkg, float* bon) {
    const int fr = lane & 15, g = lane >> 4, i = lane >> 2, c0 = (lane & 3) * 16;
    LAS float* cs = (LAS float*)scr;
    cs[lane] = 0.f;
#pragma unroll
    for (int q = 0; q < 4; ++q) *(LAS f32x4*)(cs + (i + 1) * 68 + c0 + 4 * q) = unpk4(x.e, q) * 1.4426950408889634f;
    asm volatile("" ::: "memory");
    { float t[16];
#pragma unroll
      for (int j = 0; j < 16; ++j) t[j] = cs[(j + 1) * 68 + lane];
#pragma unroll
      for (int j = 1; j < 16; ++j) t[j] += t[j - 1];
#pragma unroll
      for (int j = 0; j < 16; ++j) cs[(j + 1) * 68 + lane] = t[j]; }
    asm volatile("" ::: "memory");
    float ss = 0.f;
#pragma unroll
    for (int q = 0; q < 4; ++q) { const f32x4 kkv = unpk4(x.k, q) * *(const LAS f32x4*)(kkg + c0 + 4 * q); ss += kkv[0] * kkv[0] + kkv[1] * kkv[1] + kkv[2] * kkv[2] + kkv[3] * kkv[3]; }
    ss += dpp_mov<0xB1>(ss); ss += dpp_mov<0x4E>(ss);
    const float inv = 1.f / fmaxf(sqrtf(ss), 1e-12f);
    f32x4 cu[4], cm[4], cC[4]; float bsum = 0.f;
#pragma unroll
    for (int q = 0; q < 4; ++q) { cu[q] = *(const LAS f32x4*)(cs + (i + 1) * 68 + c0 + 4 * q); cm[q] = *(const LAS f32x4*)(cs + i * 68 + c0 + 4 * q); cC[q] = *(const LAS f32x4*)(cs + 16 * 68 + c0 + 4 * q); }
    asm volatile("s_waitcnt lgkmcnt(0)" ::: "memory");
#pragma unroll
    for (int q = 0; q < 4; ++q) {
        const f32x4 k4 = unpk4(x.k, q), a4 = unpk4(x.a, q), r4 = unpk4(x.r, q), v4 = unpk4(x.v, q);
        const f32x4 kkp4 = *(const LAS f32x4*)(kkg + c0 + 4 * q), kap4 = *(const LAS f32x4*)(kag + c0 + 4 * q), rk4 = *(const LAS f32x4*)(rkg + c0 + 4 * q);
        float qv[4], btv[4], ktv[4], rtv[4], bpv[4], kpv[4];
#pragma unroll
        for (int s = 0; s < 4; ++s) {
            const float D = __builtin_amdgcn_exp2f(-cu[q][s]), Dm = __builtin_amdgcn_exp2f(-cm[q][s]), iD = __builtin_amdgcn_exp2f(cu[q][s]), DCr = __builtin_amdgcn_exp2f(cu[q][s] - cC[q][s]);
            const float kkv = k4[s] * kkp4[s] * inv, bbv = kkv * a4[s], k2 = k4[s] * (1.f + (a4[s] - 1.f) * kap4[s]);
            qv[s] = kkv * Dm; btv[s] = bbv * iD; ktv[s] = k2 * iD; rtv[s] = r4[s] * D; bpv[s] = -(bbv * DCr); kpv[s] = k2 * DCr; bsum += r4[s] * k2 * rk4[s];
            if (i == 15) *(LAS float*)(pkg + PK_DC + (c0 + 4 * q + s) * 4) = D;
            const int o = (c0 + 4 * q + s) * 32 + (lane & 3) * 32 + i * 2;
            *(LAS unsigned short*)(scr + SCR_QT + o) = bfs(qv[s]); *(LAS unsigned short*)(pkg + PK_VT + o) = bfs(v4[s]);
            *(LAS unsigned short*)(pkg + PK_BPN + o) = bfs(bpv[s]); *(LAS unsigned short*)(pkg + PK_KP + o) = bfs(kpv[s]);
        }
        const int ro = i * RS_ + (c0 + 4 * q) * 2;
        *(LAS u32x2*)(scr + SCR_QM + ro) = (u32x2){cvt2(qv[0], qv[1]), cvt2(qv[2], qv[3])}; *(LAS u32x2*)(scr + SCR_BM + ro) = (u32x2){cvt2(btv[0], btv[1]), cvt2(btv[2], btv[3])};
        *(LAS u32x2*)(scr + SCR_KM + ro) = (u32x2){cvt2(ktv[0], ktv[1]), cvt2(ktv[2], ktv[3])}; *(LAS u32x2*)(pkg + PK_RT + ro) = (u32x2){cvt2(rtv[0], rtv[1]), cvt2(rtv[2], rtv[3])};
    }
    bsum += dpp_mov<0xB1>(bsum); bsum += dpp_mov<0x4E>(bsum);
    if ((lane & 3) == 0) bon[i * 16] = bsum;
    asm volatile("" ::: "memory");
    const f32x4 z4 = {0.f, 0.f, 0.f, 0.f};
    f32x4 L = z4, LT = z4, NkT = z4, MbT = z4, MkT = z4;
#pragma unroll
    for (int kb = 0; kb < 2; ++kb) {
        const int fo = fr * RS_ + kb * 64 + g * 16;
        const bf16x8 fq = *(const LAS bf16x8*)(scr + SCR_QM + fo), fb = *(const LAS bf16x8*)(scr + SCR_BM + fo), fk = *(const LAS bf16x8*)(scr + SCR_KM + fo), frt = *(const LAS bf16x8*)(pkg + PK_RT + fo);
        L = MFMA32(fq, fb, L); LT = MFMA32(fb, fq, LT); NkT = MFMA32(fq, fk, NkT); MbT = MFMA32(frt, fb, MbT); MkT = MFMA32(frt, fk, MkT);
    }
    f32x4 I4;
#pragma unroll
    for (int jj = 0; jj < 4; ++jj) { const int row = 4 * g + jj;
        I4[jj] = (row == fr) ? 1.f : 0.f;
        L[jj] = (fr < row) ? L[jj] : 0.f; LT[jj] = (row < fr) ? LT[jj] : 0.f; NkT[jj] = (fr < row) ? NkT[jj] : 0.f;
        MbT[jj] = (fr <= row) ? -MbT[jj] : 0.f; MkT[jj] = (fr <= row) ? MkT[jj] : 0.f; }
    const s16x4 Lb = cvt4(L), LTb = cvt4(LT);
    const f32x4 L2 = MFMA16(LTb, Lb, z4), L2T = MFMA16(Lb, LTb, z4);
    const f32x4 X1T = I4 - LT;
    const f32x4 X2T = MFMA16(cvt4(I4 + L2), cvt4(X1T), z4);
    const s16x4 L2b = cvt4(L2), L2Tb = cvt4(L2T);
    const f32x4 L4 = MFMA16(L2Tb, L2b, z4), L4T = MFMA16(L2b, L2Tb, z4);
    const f32x4 X3T = MFMA16(cvt4(I4 + L4), cvt4(X2T), z4);
    const f32x4 L8 = MFMA16(cvt4(L4T), cvt4(L4), z4);
    const f32x4 X4T = MFMA16(cvt4(I4 + L8), cvt4(X3T), z4);
    const s16x4 TA = cvt4(X4T);
    const f32x4 Nh = MFMA16(TA, cvt4(NkT), z4);
#pragma unroll
    for (int kb = 0; kb < 4; ++kb) {
        const s16x4 qf = *(const LAS s16x4*)(scr + SCR_QT + (16 * kb + fr) * 32 + kb * 32 + g * 8);
        const f32x4 Qh = MFMA16(TA, qf, z4);
#pragma unroll
        for (int jj = 0; jj < 4; ++jj) *(LAS unsigned short*)(pkg + PK_QH + (4 * g + jj) * RS_ + (16 * kb + fr) * 2) = bfs(Qh[jj]);
    }
#pragma unroll
    for (int jj = 0; jj < 4; ++jj) { const int o = (4 * g + jj) * SM_ + fr * 2;
        *(LAS unsigned short*)(pkg + PK_NH + o) = bfs(Nh[jj]); *(LAS unsigned short*)(pkg + PK_MBN + o) = bfs(MbT[jj]); *(LAS unsigned short*)(pkg + PK_MK + o) = bfs(MkT[jj]); }
}

__device__ __forceinline__ void phase_scan(const Params& p, LAS unsigned char* lds) {
    const int tid = ltid(), wave = tid >> 6, lane = tid & 63, fr = lane & 15, g = lane >> 4;
    const bf16_t* Rb = slot(p, 5); const bf16_t* Kb = slot(p, 6); const bf16_t* Vb = (const bf16_t*)p.out;
    const bf16_t* Wb = slot(p, 2); const bf16_t* Ab = slot(p, 3);
    bf16_t* Ob = slot(p, 0);
    for (int unit = BI_; unit < 128; unit += GD_) {
        const int b = unit >> 4, h = unit & 15, pw = wave & 3;
        LAS float* par = (LAS float*)(lds + SCAN_SCR_OFF + 4 * SCR_BYTES);
        const LAS float* kkg = par; const LAS float* kag = par + 64; const LAS float* rkg = par + 128;
        float* bong = (float*)(p.ws + WS_BON) + ((size_t)b * SEQ_) * 16 + h;
        ScanRaw cur, nxt;
        const size_t hbase = ((size_t)b * SEQ_) * 1024 + h * 64;
        LAS unsigned char* scr = lds + SCAN_SCR_OFF + pw * SCR_BYTES;
        __syncthreads();
        if (tid < 192) par[tid] = (tid < 64 ? p.in[I_KK] : tid < 128 ? p.in[I_KA] : p.in[I_RK])[h * 64 + (tid & 63)];
        __syncthreads();
        if (wave >= 4) { scan_load(cur, Rb, Wb, Kb, Vb, Ab, hbase + (size_t)(pw * 16) * 1024, lane); scan_load(nxt, Rb, Wb, Kb, Vb, Ab, hbase + (size_t)((4 + pw) * 16) * 1024, lane);
                         scan_produce(cur, lds + pw * PK_BYTES, scr, lane, kkg, kag, rkg, bong + (size_t)(pw * 16) * 16); cur = nxt; }
        __syncthreads();
        const f32x4 z4 = {0.f, 0.f, 0.f, 0.f};
        f32x4 G[4] = {z4, z4, z4, z4};
        for (int R = 0; R < SEQ_ / 64; ++R) {
            if (wave < 4) {
#pragma unroll 1
                for (int qq = 0; qq < 4; ++qq) {
                    const LAS unsigned char* pk = lds + ((R & 1) * 4 + qq) * PK_BYTES;
                    const s16x4 vt = *(const LAS s16x4*)(pk + PK_VT + (16 * wave + fr) * 32 + wave * 32 + g * 8);
                    s16x4 Gb[4];
#pragma unroll
                    for (int kb = 0; kb < 4; ++kb) Gb[kb] = cvt4(G[kb]);
                    f32x4 PT = MFMA16(*(const LAS s16x4*)(pk + PK_NH + fr * SM_ + g * 8), vt, z4);
                    f32x4 OT = MFMA16(*(const LAS s16x4*)(pk + PK_MK + fr * SM_ + g * 8), vt, z4);
#pragma unroll
                    for (int kb = 0; kb < 4; ++kb) {
                        PT = MFMA16(*(const LAS s16x4*)(pk + PK_QH + fr * RS_ + (16 * kb + 4 * g) * 2), Gb[kb], PT);
                        OT = MFMA16(*(const LAS s16x4*)(pk + PK_RT + fr * RS_ + (16 * kb + 4 * g) * 2), Gb[kb], OT);
                    }
                    const s16x4 PTb = cvt4(PT);
                    OT = MFMA16(*(const LAS s16x4*)(pk + PK_MBN + fr * SM_ + g * 8), PTb, OT);
#pragma unroll
                    for (int kb = 0; kb < 4; ++kb) {
                        const f32x4 dc = *(const LAS f32x4*)(pk + PK_DC + (16 * kb + 4 * g) * 4);
                        f32x4 t = G[kb] * dc;
                        t = MFMA16(*(const LAS s16x4*)(pk + PK_BPN + (16 * kb + fr) * 32 + kb * 32 + g * 8), PTb, t);
                        G[kb] = MFMA16(*(const LAS s16x4*)(pk + PK_KP + (16 * kb + fr) * 32 + kb * 32 + g * 8), vt, t);
                    }
                    bf16_t* op = Ob + hbase + (size_t)((R * 4 + qq) * 16 + 4 * g) * 1024 + 16 * wave + fr;
#pragma unroll
                    for (int jj = 0; jj < 4; ++jj) { const float nb = dpp_mov<0xB1>(OT[jj]); const unsigned w2 = cvt2(OT[jj], nb); if ((fr & 1) == 0) *(unsigned*)(op + (size_t)jj * 1024) = w2; }
                }
            } else if (R + 1 < SEQ_ / 64) {
                if (R + 2 < SEQ_ / 64) scan_load(nxt, Rb, Wb, Kb, Vb, Ab, hbase + (size_t)(((R + 2) * 4 + pw) * 16) * 1024, lane);
                scan_produce(cur, lds + (((R + 1) & 1) * 4 + pw) * PK_BYTES, scr, lane, kkg, kag, rkg, bong + (size_t)(((R + 1) * 4 + pw) * 16) * 16); cur = nxt;
            }
            __syncthreads();
        }
    }
}
__device__ __forceinline__ void phase_post(const Params& p) {
    const bf16_t* Vb = (const bf16_t*)p.out; bf16_t* Gb = slot(p, 4);
    const bf16_t* Ob = slot(p, 0); const float* Bon = (const float*)(p.ws + WS_BON);
    const size_t total = (size_t)T_ * 256, stride = (size_t)GD_ * 512;
    const int tid0 = ltid();
    const int ch = (tid0 & 255) * 4;
    const f32x4 lg = *(const f32x4*)(p.in[I_LNXG] + ch), lb = *(const f32x4*)(p.in[I_LNXB] + ch);
    for (size_t g0 = (size_t)BI_ * 512 + tid0; g0 < total; g0 += 2 * stride) {
        u32x2 o2[2]; u32x2 uv2[2], ug2[2]; float bs2[2]; bool ok[2];
#pragma unroll
        for (int q = 0; q < 2; ++q) { const size_t gid = g0 + q * stride; ok[q] = gid < total; const size_t eo = (ok[q] ? gid : g0) * 4;
            o2[q] = *(const u32x2*)(Ob + eo); uv2[q] = *(const u32x2*)(Vb + eo); ug2[q] = *(const u32x2*)(Gb + eo); bs2[q] = Bon[(ok[q] ? gid : g0) >> 4]; }
#pragma unroll
        for (int q = 0; q < 2; ++q) {
            const size_t gid = g0 + q * stride; const size_t eo = gid * 4;
            const f32x4 o = {bf_lo(o2[q].x), bf_hi(o2[q].x), bf_lo(o2[q].y), bf_hi(o2[q].y)}; const u32x2 uv = uv2[q], ug = ug2[q]; const float bs = bs2[q];
            const f32x4 v4 = {bf_lo(uv.x), bf_hi(uv.x), bf_lo(uv.y), bf_hi(uv.y)}, g4 = {bf_lo(ug.x), bf_hi(ug.x), bf_lo(ug.y), bf_hi(ug.y)};
            float s = o[0] + o[1] + o[2] + o[3];
            s += dpp_mov<0xB1>(s); s += dpp_mov<0x4E>(s); s += dpp_mov<0x141>(s); s += dpp_mov<0x140>(s);
            const float mean = s * (1.f / 64.f);
            const f32x4 d = o - mean; float qq = d[0] * d[0] + d[1] * d[1] + d[2] * d[2] + d[3] * d[3];
            qq += dpp_mov<0xB1>(qq); qq += dpp_mov<0x4E>(qq); qq += dpp_mov<0x141>(qq); qq += dpp_mov<0x140>(qq);
            const float rstd = rsqrtf(qq * (1.f / 64.f) + 64e-5f);
            const f32x4 y = (d * rstd * lg + lb + bs * v4) * g4;
            u32x2 w; w.x = cvt_pk_bf16(y[0], y[1]); w.y = cvt_pk_bf16(y[2], y[3]);
            if (ok[q]) *(u32x2*)(Gb + eo) = w;
        }
    }
}

__device__ __forceinline__ void phase_conv(const Params& p, int l) {
    const bf16_t* Gt = slot(p, 1); bf16_t* Vl = slot(p, 1) + (size_t)T_ * FF_;
    const float* cw = p.in[I_CONVW] + (size_t)l * 3 * FF_; const float* cb = p.in[I_CONVB] + (size_t)l * FF_;
    constexpr int CH = FF_ / 8, RUN = 32;
    const int total = (T_ / RUN) * CH;
    const int tid0 = ltid();
    for (int id = BI_ * 512 + tid0; id < total; id += GD_ * 512) {
        const int cc = (id % CH) * 8, t0 = (id / CH) * RUN;
        float w0[8], w1[8], w2[8], bb[8], g1[8], g2[8];
#pragma unroll
        for (int e = 0; e < 8; ++e) { w0[e] = cw[cc + e]; w1[e] = cw[FF_ + cc + e]; w2[e] = cw[2 * FF_ + cc + e]; bb[e] = cb[cc + e]; g1[e] = 0.f; g2[e] = 0.f; }
        if ((t0 & (SEQ_ - 1)) != 0) {
            const u32x4 a = *(const u32x4*)(Gt + (size_t)(t0 - 1) * FF_ + cc), b = *(const u32x4*)(Gt + (size_t)(t0 - 2) * FF_ + cc);
            g1[0] = bf_lo(a.x); g1[1] = bf_hi(a.x); g1[2] = bf_lo(a.y); g1[3] = bf_hi(a.y); g1[4] = bf_lo(a.z); g1[5] = bf_hi(a.z); g1[6] = bf_lo(a.w); g1[7] = bf_hi(a.w);
            g2[0] = bf_lo(b.x); g2[1] = bf_hi(b.x); g2[2] = bf_lo(b.y); g2[3] = bf_hi(b.y); g2[4] = bf_lo(b.z); g2[5] = bf_hi(b.z); g2[6] = bf_lo(b.w); g2[7] = bf_hi(b.w);
        }
        for (int r = 0; r < RUN; ++r) {
            const size_t o = (size_t)(t0 + r) * FF_ + cc;
            const u32x4 a = *(const u32x4*)(Gt + o), vv = *(const u32x4*)(Vl + o);
            float g0[8] = {bf_lo(a.x), bf_hi(a.x), bf_lo(a.y), bf_hi(a.y), bf_lo(a.z), bf_hi(a.z), bf_lo(a.w), bf_hi(a.w)};
            float v8[8] = {bf_lo(vv.x), bf_hi(vv.x), bf_lo(vv.y), bf_hi(vv.y), bf_lo(vv.z), bf_hi(vv.z), bf_lo(vv.w), bf_hi(vv.w)};
            float hh[8];
#pragma unroll
            for (int e = 0; e < 8; ++e) { const float cv = g2[e] * w0[e] + g1[e] * w1[e] + g0[e] * w2[e] + bb[e]; hh[e] = cv * sigmoidf_(cv) * v8[e]; g2[e] = g1[e]; g1[e] = g0[e]; }
            u32x4 w; w.x = cvt_pk_bf16(hh[0], hh[1]); w.y = cvt_pk_bf16(hh[2], hh[3]); w.z = cvt_pk_bf16(hh[4], hh[5]); w.w = cvt_pk_bf16(hh[6], hh[7]);
            *(u32x4*)(Vl + o) = w;
        }
    }
}

__device__ __forceinline__ void phase_sgu(const Params& p, LAS unsigned char* lds) {
    LAS float* stats = (LAS float*)lds;
    LAS unsigned short* vTb = (LAS unsigned short*)(lds + 1024);
    const bf16_t* U = slot(p, 1); const bf16_t* V = slot(p, 2); bf16_t* Go = slot(p, 3);
    const bf16_t* Ws = wsW(p, W_GS);
    const int tid = ltid(), wave = tid >> 6, lane = tid & 63, fr = lane & 15, fq = lane >> 4;
    const int ls = tid >> 2, dq = (tid & 3) * 16;
    for (int unit = BI_; unit < T_ / 128; unit += GD_) {
        const size_t t0 = (size_t)unit * 128;
        __syncthreads();
        { const int row = tid >> 2, q = tid & 3; const f32x2 pr = *(const f32x2*)(p.out + (t0 + row) * 8 + q * 2); float s = pr.x, ss = pr.y;
          s += __shfl_xor(s, 1, 64); s += __shfl_xor(s, 2, 64); ss += __shfl_xor(ss, 1, 64); ss += __shfl_xor(ss, 2, 64);
          const float mean = s * (1.f / 1024.f), var = fmaxf(ss * (1.f / 1024.f) - mean * mean, 0.f);
          if (q == 0) { stats[row * 2] = mean; stats[row * 2 + 1] = rsqrtf(var + 1e-5f); } }
        const bf16_t* vrow = V + (t0 + ls) * 1024 + dq;
        u32x4 raw0 = *(const u32x4*)(vrow), raw1 = *(const u32x4*)(vrow + 8);
        f32x4 lgv[4], lbv[4];
#pragma unroll
        for (int i = 0; i < 4; ++i) { lgv[i] = *(const f32x4*)(p.in[I_GLNG] + dq + 4 * i); lbv[i] = *(const f32x4*)(p.in[I_GLNB] + dq + 4 * i); }
        __syncthreads();
        const float mean = stats[ls * 2], rstd = stats[ls * 2 + 1];
        const int t = 16 * wave + fr;
        for (int g = 0; g < 16; ++g) {
            LAS unsigned short* vT = vTb + (g & 1) * (64 * 136);
            u32x2 uu[4];
#pragma unroll
            for (int n = 0; n < 4; ++n) uu[n] = *(const u32x2*)(U + (t0 + t) * 1024 + g * 64 + n * 16 + fq * 4);
            const int kmax = (16 * wave + 15) >> 5;
            bf16x8 afv[4];
#pragma unroll
            for (int kk = 0; kk < 4; ++kk) if (kk <= kmax) afv[kk] = *(const bf16x8*)(Ws + ((size_t)g * 128 + 16 * wave + fr) * 128 + kk * 32 + fq * 8);
            const float bias = p.in[I_GBS][g * 128 + t];
            {
#pragma unroll
              for (int i = 0; i < 2; ++i) { const u32x4 a = i ? raw1 : raw0;
                  const float f[8] = {bf_lo(a.x), bf_hi(a.x), bf_lo(a.y), bf_hi(a.y), bf_lo(a.z), bf_hi(a.z), bf_lo(a.w), bf_hi(a.w)};
#pragma unroll
                  for (int e = 0; e < 8; ++e) vT[(dq + i * 8 + e) * 136 + ls] = bf1((f[e] - mean) * rstd * lgv[i * 2 + (e >> 2)][e & 3] + lbv[i * 2 + (e >> 2)][e & 3]); } }
            if (g + 1 < 16) { raw0 = *(const u32x4*)(vrow + (g + 1) * 64); raw1 = *(const u32x4*)(vrow + (g + 1) * 64 + 8);
#pragma unroll
                for (int i = 0; i < 4; ++i) { lgv[i] = *(const f32x4*)(p.in[I_GLNG] + (g + 1) * 64 + dq + 4 * i); lbv[i] = *(const f32x4*)(p.in[I_GLNB] + (g + 1) * 64 + dq + 4 * i); } }
            asm volatile("s_waitcnt lgkmcnt(0)" ::: "memory"); __builtin_amdgcn_s_barrier(); asm volatile("" ::: "memory");
            f32x4 acc[4];
#pragma unroll
            for (int n = 0; n < 4; ++n) acc[n] = (f32x4){0.f, 0.f, 0.f, 0.f};
#pragma unroll
            for (int kk = 0; kk < 4; ++kk) if (kk <= kmax) {
#pragma unroll
                for (int n = 0; n < 4; ++n) { const bf16x8 bfr = *(const LAS bf16x8*)(vT + (n * 16 + fr) * 136 + kk * 32 + fq * 8);
                    acc[n] = __builtin_amdgcn_mfma_f32_16x16x32_bf16(bfr, afv[kk], acc[n], 0, 0, 0); }
            }
            {
#pragma unroll
              for (int n = 0; n < 4; ++n) { const size_t o = (t0 + t) * 1024 + g * 64 + n * 16 + fq * 4;
                  u32x2 w; w.x = cvt_pk_bf16(bf_lo(uu[n].x) * (acc[n][0] + bias), bf_hi(uu[n].x) * (acc[n][1] + bias)); w.y = cvt_pk_bf16(bf_lo(uu[n].y) * (acc[n][2] + bias), bf_hi(uu[n].y) * (acc[n][3] + bias));
                  *(u32x2*)(Go + o) = w; } }
        }
    }
}

#define XB_TMO      128
#define XB_XCNT(j)  (256  + 64 * (j))
#define XB_XSUB(j)  (1280 + 64 * (j))
#define XB_XGEN(j)  (2304 + 64 * (j))
#define XB_TOP      3328
#define XB_TOPGEN   3392
#define XCD_BAR_WORDS 3456
#define XB_SPIN_CAP (1u << 18)

__device__ __forceinline__ unsigned xb_ld(unsigned* p)              { return __hip_atomic_load(p, __ATOMIC_RELAXED, __HIP_MEMORY_SCOPE_AGENT); }
__device__ __forceinline__ unsigned xb_add(unsigned* p, unsigned v) { return __hip_atomic_fetch_add(p, v, __ATOMIC_RELAXED, __HIP_MEMORY_SCOPE_AGENT); }
__device__ __forceinline__ unsigned xb_xcc_id() { return (unsigned)__builtin_amdgcn_s_getreg((3 << 11) | 20) & 0xFu; }
#define XB_SPIN(cond, bar) do { unsigned _sp = 0; while (cond) { __builtin_amdgcn_s_sleep(1); \
    if ((++_sp & 255u) == 0u) { if (xb_ld(&(bar)[XB_TMO])) break; if (_sp > XB_SPIN_CAP) { atomicAdd(&(bar)[XB_TMO], 1u); break; } } } } while (0)

struct XcdBarrier {
    unsigned* bar; unsigned x;
    volatile LAS unsigned* st;
};

__device__ __forceinline__ XcdBarrier xcd_barrier_post(unsigned* bar, volatile LAS unsigned* st) {
    XcdBarrier b; b.bar = bar; b.x = xb_xcc_id(); b.st = st;
    if (threadIdx.x == 0) (void)xb_add(&bar[XB_XCNT(b.x)], 1u);
    return b;
}
__device__ __forceinline__ void xcd_barrier_complete(unsigned* bar, unsigned x, unsigned& nloc, unsigned& nx) {
    const unsigned G = gridDim.x * gridDim.y * gridDim.z;
    unsigned sum, cnt, mine, sp = 0u;
    for (;;) {
        sum = 0u; cnt = 0u; mine = 0u;
#pragma unroll
        for (unsigned j = 0; j < 16; ++j) { const unsigned c = xb_ld(&bar[XB_XCNT(j)]); sum += c; cnt += (c > 0u) ? 1u : 0u; mine = (j == x) ? c : mine; }
        if (sum == G) break;
        __builtin_amdgcn_s_sleep(1);
        if ((++sp & 255u) == 0u) { if (xb_ld(&bar[XB_TMO])) break; if (sp > XB_SPIN_CAP) { atomicAdd(&bar[XB_TMO], 1u); break; } }
    }
    nloc = mine > 0u ? mine : 1u; nx = cnt > 0u ? cnt : 1u;
}

__device__ __forceinline__ void xcd_barrier(const XcdBarrier& b) {
    asm volatile("s_waitcnt vmcnt(0)" ::: "memory");
    __syncthreads();
    if (threadIdx.x == 0) {
        unsigned* bar = b.bar;
        __builtin_amdgcn_s_waitcnt(0);
        unsigned nloc = b.st[0], nx = b.st[1];
        if (nloc == 0u) { xcd_barrier_complete(bar, b.x, nloc, nx); b.st[0] = nloc; b.st[1] = nx; }
        const unsigned old = xb_add(&bar[XB_XSUB(b.x)], 1u);
        const unsigned gen = old / nloc;
        if (old + 1u == (gen + 1u) * nloc) {
            __builtin_amdgcn_fence(__ATOMIC_RELEASE, "agent");
            asm volatile("s_waitcnt vmcnt(0)" ::: "memory");
            const unsigned og = xb_add(&bar[XB_TOP], 1u);
            const unsigned tg = og / nx;
            if (og + 1u == (tg + 1u) * nx) xb_add(&bar[XB_TOPGEN], 1u);
            else XB_SPIN(xb_ld(&bar[XB_TOPGEN]) == tg, bar);
            __builtin_amdgcn_fence(__ATOMIC_ACQUIRE, "agent");
            xb_add(&bar[XB_XGEN(b.x)], 1u);
            asm volatile("s_waitcnt vmcnt(0)" ::: "memory");
        } else {
            XB_SPIN(xb_ld(&bar[XB_XGEN(b.x)]) == gen, bar);
            __builtin_amdgcn_fence(__ATOMIC_ACQUIRE, "agent");
            asm volatile("s_waitcnt vmcnt(0)" ::: "memory");
        }
    }
    __syncthreads();
}

__device__ __forceinline__ pg8::Gemm mk_gemm(const bf16_t* A, const bf16_t* Bt, int lda, int ldb, int K, int nM, int nN) {
    pg8::Gemm g; g.A = A; g.Bt = Bt; g.lda = lda; g.ldb = ldb; g.K = K; g.nM = nM; g.nN = nN; g.nZ = 1; g.zdiv = 1; g.zA1 = g.zA2 = g.zB1 = g.zB2 = 0; g.ksplit = 1 << 30; g.adelta = 0; g.ovl = 0; g.koffpn = 1 << 30; g.koff = 0; g.pm0 = 0; return g;
}
__device__ __forceinline__ pg8::EpiBfData mk_epi(bf16_t* O, int ldc) {
    pg8::EpiBfData e; e.O = O; e.ldc = ldc; e.zdiv = 1; e.zO1 = e.zO2 = 0; e.split_cols = 0; e.split_stride = 0; e.p0 = nullptr; e.p1 = nullptr; e.scale = 1.f; e.ss = nullptr; e.vs = nullptr; e.red = nullptr; return e;
}
constexpr int N_STEPS = 34;
__device__ __forceinline__ bool need_sync(int st) { return !(st == 2 || st == 3 || st == 5 || st == 6); }
__device__ __forceinline__ bool skip_step(int st) { return st == 1 || st == 2 || (MK_ONE_LAUNCH && (st == 19 || st == 32)) || st == 11 || st == 16 || st == 20 || st == 24 || st == 29 || st == 18 || st == 31; }
enum { K_NONE = 0, K_BF, K_LORA1, K_LORA2, K_GELU, K_RES, K_SOFTMAX, K_CONV };
struct Desc { pg8::Gemm g; pg8::EpiBfData e; const float* res; float* ssw; int kind; };
__device__ __forceinline__ void get_desc(const Params& p, int st, Desc& d) {
    const bf16_t* MEMN = (const bf16_t*)(p.ws + WS_MEMN); bf16_t* KM = (bf16_t*)(p.ws + WS_KM); bf16_t* VT = (bf16_t*)(p.ws + WS_VT);
    bf16_t* LMID = (bf16_t*)p.out + (size_t)T_ * 1024; float* SS = (float*)(p.ws + WS_SS);
    int l = 0, cs = -1;
    if (st >= 11 && st <= 19) cs = st - 11; else if (st >= 24 && st <= 32) { cs = st - 24; l = 1; }
    int kind = K_NONE; pg8::Gemm g = mk_gemm(nullptr, nullptr, 0, 0, 0, 0, 0); pg8::EpiBfData e = mk_epi(nullptr, 0);
    const float* res = nullptr; float* ssw = nullptr;
    if (st == 1) { g = mk_gemm(MEMN, wsW(p, W_CAKV), 1024, 1024, 1024, 8, 4); g.nZ = 2; g.zB1 = 2 * Mi; e = mk_epi(KM, 1024); e.zO1 = 2 * Mi; kind = K_BF; }
    else if (st == 2) { g = mk_gemm(wsW(p, W_CAKV + Mi), MEMN, 1024, 1024, 1024, 4, 1); g.nZ = 16; g.zdiv = 8; g.zA1 = 2 * Mi; g.zB2 = 256 * 1024;
                        e = mk_epi(VT, 256); e.zdiv = 8; e.zO1 = 2 * Mi; e.zO2 = 1024 * 256; kind = K_BF; }
    else if (st == 4) { g = mk_gemm(slot(p, 2), wsW(p, W_RKV), 1024, 1024, 1024, 256, 4); g.nZ = 2; g.zA1 = (long)(SLOT / 2); g.zB1 = (long)Mi; e = mk_epi(slot(p, 5), 1024); e.zO1 = (long)(SLOT / 2); kind = K_BF; }
    else if (st == 5) { g = mk_gemm(slot(p, 4), wsW(p, W_RKV + 2 * Mi), 1024, 1024, 1024, 256, 4); e = mk_epi((bf16_t*)p.out, 1024); kind = K_BF; }
    else if (st == 6) { g = mk_gemm(slot(p, 2), wsW(p, W_L1), 1024, 2048, 2048, 256, 1); g.ksplit = 16; g.adelta = -(long)SLOT - 2048; e = mk_epi(LMID, 256); kind = K_LORA1; }
    else if (st == 7) { g = mk_gemm(LMID, wsW(p, W_L2), 256, 256, 128, 256, 12); g.koffpn = 8; g.koff = 128;   e = mk_epi(slot(p, 2), 1024); e.split_cols = 1024; e.split_stride = (long)(SLOT / 2); e.p0 = p.in[I_W0]; e.p1 = p.in[I_A0]; kind = K_LORA2; }
    else if (st == 10) { g = mk_gemm(slot(p, 4), wsW(p, W_RWO), 1024, 1024, 1024, 256, 4); res = p.in[I_X]; ssw = SS; kind = K_RES; }
    else if (cs == 1) { g = mk_gemm(slot(p, 0), wsW(p, W_CAQ + l * Mi), 1024, 1024, 1024, 256, 4); e = mk_epi(slot(p, 1), 1024); e.scale = 0.0625f; e.ss = SS + (l ? 3 : 0) * 4 * T_; kind = K_BF; }
    else if (cs == 2) { g = mk_gemm(slot(p, 1), KM + (size_t)l * 2 * Mi, 1024, 1024, 256, 32, 1); g.nZ = 32; g.zdiv = 4; g.zA1 = (long)SEQ_ * 1024; g.zA2 = 256; g.zB1 = 256 * 1024; g.zB2 = 256; kind = K_SOFTMAX; }
    else if (cs == 3) { g = mk_gemm(slot(p, 2), VT + (size_t)l * 2 * Mi, 1024, 256, 256, 32, 1); g.nZ = 32; g.zdiv = 4; g.zA1 = (long)SEQ_ * 1024; g.zA2 = 256; g.zB1 = 1024 * 256; g.zB2 = 256 * 256;
                        e = mk_epi(slot(p, 3), 1024); e.zdiv = 4; e.zO1 = (long)SEQ_ * 1024; e.zO2 = 256; kind = K_BF; }
    else if (cs == 4) { g = mk_gemm(slot(p, 3), wsW(p, W_CAO + l * Mi), 1024, 1024, 1024, 256, 4); ssw = SS + (l ? 4 : 1) * 4 * T_; kind = K_RES; }
    else if (cs == 6) { g = mk_gemm(slot(p, 0), wsW(p, W_UP + (size_t)l * 5632 * 1024), 1024, 1024, 1024, 264, 22); g.ovl = 1; e.ss = SS + (l ? 4 : 1) * 4 * T_; e.p0 = p.in[I_CONVW] + (size_t)l * 3 * FF_; e.p1 = p.in[I_CONVB] + (size_t)l * FF_; kind = K_CONV; }
    else if (cs == 8) { g = mk_gemm(slot(p, 1), wsW(p, W_DOWN + (size_t)l * 2816 * 1024), FF_, FF_, FF_, 256, 4); if (l == 0) ssw = SS + 2 * 4 * T_; kind = K_RES; }
    else if (st == 21) { g = mk_gemm(slot(p, 0), wsW(p, W_GIN), 1024, 1024, 1024, 256, 8); e = mk_epi(slot(p, 1), 1024); e.split_cols = 1024; e.split_stride = (long)(SLOT / 2); e.ss = SS + 2 * 4 * T_; kind = K_GELU; }
    else if (st == 23) { g = mk_gemm(slot(p, 3), wsW(p, W_GOUT), 1024, 1024, 1024, 256, 4); ssw = SS + 3 * 4 * T_; kind = K_RES; }
    d.g = g; d.e = e; d.res = res; d.ssw = ssw; d.kind = kind;
}
namespace pg8 {
template <int OP> struct MakeEpi<EpiBf<OP>> { static __device__ __forceinline__ EpiBf<OP> make(const Params& p, int st, LAS unsigned char* lds) { Desc d; get_desc(p, st, d); EpiBf<OP> E; (EpiBfData&)E = d.e; E.red = (LAS float*)(lds + EXTRA_OFF); E.vs = (OP == OP_GELU) ? p.out : nullptr; return E; } };
template <> struct MakeEpi<EpiRes> { static __device__ __forceinline__ EpiRes make(const Params& p, int st, LAS unsigned char* lds) { Desc d; get_desc(p, st, d); return EpiRes{d.res, slot(p, 0), d.ssw, 1024, (LAS float*)(lds + EXTRA_OFF)}; } };
template <> struct MakeEpi<EpiConv> { static __device__ __forceinline__ EpiConv make(const Params& p, int st, LAS unsigned char* lds) { Desc d; get_desc(p, st, d); return EpiConv{slot(p, 1), d.e.p0, d.e.p1, d.e.ss, (LAS float*)(lds + EXTRA_OFF)}; } };
template <> struct MakeEpi<EpiSoftmax> { static __device__ __forceinline__ EpiSoftmax make(const Params& p, int, LAS unsigned char* lds) { return EpiSoftmax{slot(p, 2), (LAS float*)(lds + EXTRA_OFF)}; } };
}

__global__ void __launch_bounds__(512) mega(Params p) {
    extern __shared__ __attribute__((aligned(16))) unsigned char lds_raw[];
    LAS unsigned char* lds = (LAS unsigned char*)lds_raw;
    cg::grid_group grid = cg::this_grid();
#if MK_ONE_LAUNCH
    volatile LAS unsigned* xst = (volatile LAS unsigned*)(lds + LDS_BYTES - 64);
    if (threadIdx.x == 0) { xst[0] = 0u; xst[1] = 0u; }
    __syncthreads();
    const XcdBarrier xbar = xcd_barrier_post((unsigned*)(p.ws + WS_BAR), xst);
    for (int st = p.ph_lo; st < p.ph_hi; ++st) {
      if (skip_step(st)) continue;
      const int reps = 1 + (int)(((unsigned long long)(REP_MASK) >> st) & 1ull);
      for (int rep = 0; rep < reps; ++rep) {
        if ((st > p.ph_lo && need_sync(st)) || rep > 0) { if (st == 4 && rep == 0) grid.sync(); else xcd_barrier(xbar); }
#else
    { { const int st = p.ph_lo;
#endif
        const int l = (st >= 24) ? 1 : 0;
        if (st == 0) phase_prologue(p, lds);
        else if (st == 3) phase_r0(p);
        else if (st == 8) { if (BI_ < 128 || GD_ <= 128) phase_scan(p, lds); if (GD_ <= 128) { phase_convert_late(p, lds, BI_, GD_); __syncthreads();
                                 Desc d1; get_desc(p, 1, d1); pg8::gemm_phase<pg8::EpiBf<pg8::OP_NONE>, false>(lds, d1.g, p, 1);
                                 Desc d2; get_desc(p, 2, d2); pg8::gemm_phase<pg8::EpiBf<pg8::OP_NONE>, false>(lds, d2.g, p, 2); }
                            else if (BI_ >= 128) { phase_convert_late(p, lds, BI_ - 128, GD_ - 128); __syncthreads();
                                 Desc d1; get_desc(p, 1, d1); pg8::gemm_phase<pg8::EpiBf<pg8::OP_NONE>, false>(lds, d1.g, p, 1, GD_ - 128, BI_ - 128);
                                 Desc d2; get_desc(p, 2, d2); pg8::gemm_phase<pg8::EpiBf<pg8::OP_NONE>, false>(lds, d2.g, p, 2, GD_ - 128, BI_ - 128); } }
        else if (st == 9) phase_post(p);
        else if (st == 22) phase_sgu(p, lds);
        else if (st == 33) phase_final(slot(p, 0), p.out, p.in[I_NFIN]);
        else {
            Desc d; get_desc(p, st, d);
            if (d.kind == K_BF) pg8::gemm_phase<pg8::EpiBf<pg8::OP_NONE>, false>(lds, d.g, p, st);
            else if (d.kind == K_LORA1) pg8::gemm_phase<pg8::EpiBf<pg8::OP_LORA1>, true>(lds, d.g, p, st);
            else if (d.kind == K_LORA2) pg8::gemm_phase<pg8::EpiBf<pg8::OP_LORA2>, false>(lds, d.g, p, st);
            else if (d.kind == K_GELU) pg8::gemm_phase<pg8::EpiBf<pg8::OP_GELU>, false>(lds, d.g, p, st);
            else if (d.kind == K_RES) pg8::gemm_phase<pg8::EpiRes, false>(lds, d.g, p, st);
            else if (d.kind == K_SOFTMAX) pg8::gemm_phase<pg8::EpiSoftmax, false>(lds, d.g, p, st);
#if MK_ONE_LAUNCH
            else if (d.kind == K_CONV) {
                for (int half = 0; half < 2; ++half) {
                    pg8::Gemm gu = d.g; gu.nM = 132; gu.pm0 = 132 * half; pg8::gemm_phase<pg8::EpiConv, false>(lds, gu, p, st);
                    xcd_barrier(xbar);
                    Desc dd; get_desc(p, st + 2, dd); pg8::Gemm gd = dd.g; gd.nM = 128; gd.pm0 = 128 * half; pg8::gemm_phase<pg8::EpiRes, false>(lds, gd, p, st + 2);
                    if (half == 0) xcd_barrier(xbar);
                }
            }
#else
            else if (d.kind == K_CONV) pg8::gemm_phase<pg8::EpiConv, false>(lds, d.g, p, st);
#endif
        }
    } }
}

extern "C" void kernel_launch(void* const* d_in, const int* in_sizes, int n_in, void* d_out, int out_size, void* d_ws, size_t ws_size, hipStream_t stream) {
    static int grid = 0;
    if (grid == 0) {
        int dev = 0, cus = 0, per_cu = 0;
        (void)hipGetDevice(&dev); (void)hipDeviceGetAttribute(&cus, hipDeviceAttributeMultiprocessorCount, dev);
        if (hipFuncSetAttribute((const void*)mega, hipFuncAttributeMaxDynamicSharedMemorySize, LDS_BYTES) != hipSuccess) fprintf(stderr, "kernel_launch: hipFuncSetAttribute failed\n");
        if (hipOccupancyMaxActiveBlocksPerMultiprocessor(&per_cu, (const void*)mega, 512, LDS_BYTES) != hipSuccess || per_cu < 1) { fprintf(stderr, "kernel_launch: occupancy query gave %d\n", per_cu); per_cu = 1; }
        (void)hipGetLastError();
        grid = cus * per_cu; if (grid <= 0) grid = 256;
    }
    Params p{};
    for (int i = 0; i < 36; ++i) p.in[i] = (const float*)d_in[i];
    p.out = (float*)d_out; p.ws = (unsigned char*)d_ws;
#if MK_ONE_LAUNCH
    p.ph_lo = 0; p.ph_hi = N_STEPS;
    (void)hipMemsetAsync((char*)d_ws + WS_BAR, 0, 16384, stream);
    void* args[] = {&p};
    hipError_t e = hipLaunchCooperativeKernel((const void*)mega, dim3(grid), dim3(512), args, LDS_BYTES, stream);
    if (e != hipSuccess) fprintf(stderr, "cooperative launch failed: %s (grid %d)\n", hipGetErrorString(e), grid);
#else
    for (int st = 0; st < N_STEPS; ++st) { p.ph_lo = st; p.ph_hi = st + 1; hipLaunchKernelGGL(mega, dim3(grid), dim3(512), LDS_BYTES, stream, p); }
#endif
}
```

```cpp
#include <hip/hip_runtime.h>
#include <hip/hip_cooperative_groups.h>
#include <cstdio>
#include <cstdint>
namespace cg = cooperative_groups;

#ifndef REP_MASK
#define REP_MASK 0ull
#endif
#ifndef MK_ONE_LAUNCH
#define MK_ONE_LAUNCH 1
#endif

#define LAS __attribute__((address_space(3)))
typedef unsigned short bf16_t;
typedef short bf16x8 __attribute__((ext_vector_type(8)));
typedef float f32x4 __attribute__((ext_vector_type(4)));
typedef float f32x2 __attribute__((ext_vector_type(2)));
typedef unsigned u32x4 __attribute__((ext_vector_type(4)));
typedef unsigned u32x2 __attribute__((ext_vector_type(2)));

constexpr int T_ = 65536, D_ = 1024, SEQ_ = 8192, NB_ = 8, FF_ = 2816;
constexpr size_t MiB = (size_t)1 << 20;
constexpr size_t Mi = (size_t)1 << 20;
constexpr size_t W_RKV = 0, W_L1 = 3 * Mi, W_L2 = W_L1 + 512 * 1024, W_RWO = W_L2 + 768 * 1024, W_GIN = W_RWO + Mi, W_GOUT = W_GIN + 2 * Mi,
                 W_GS = W_GOUT + Mi, W_CAQ = W_GS + 256 * 1024, W_CAKV = W_CAQ + 2 * Mi, W_CAO = W_CAKV + 4 * Mi, W_UP = W_CAO + 2 * Mi,
                 W_DOWN = W_UP + 2 * (size_t)5632 * 1024, W_END = W_DOWN + 2 * (size_t)2816 * 1024;
static_assert(W_END * 2 <= 66 * MiB, "weights");
constexpr size_t WS_BON = 91 * MiB;
constexpr size_t WS_BAR = 95 * MiB;
constexpr size_t WS_SS = 86 * MiB;
constexpr size_t WS_MEMN = 66 * MiB, WS_KM = 70 * MiB, WS_VT = 78 * MiB, WS_BUF = 96 * MiB, SLOT = 128 * MiB;
constexpr int LDS_BYTES = 147456;
constexpr int EXTRA_OFF = 131072;

__device__ __forceinline__ unsigned cvt_pk_bf16(float lo, float hi) { unsigned r; asm volatile("v_cvt_pk_bf16_f32 %0, %1, %2" : "=v"(r) : "v"(lo), "v"(hi)); return r; }
__device__ __forceinline__ float bf_lo(unsigned u) { return __builtin_bit_cast(float, u << 16); }
__device__ __forceinline__ float bf_hi(unsigned u) { return __builtin_bit_cast(float, u & 0xffff0000u); }
__device__ __forceinline__ float sigmoidf_(float x) { return __builtin_amdgcn_rcpf(1.f + __expf(-x)); }
__device__ __forceinline__ float tanhf_(float x) { return 1.f - 2.f * __builtin_amdgcn_rcpf(1.f + __expf(2.f * x)); }
__device__ __forceinline__ float gelu_tanh(float x) { return x * sigmoidf_(1.5957691216f * (x + 0.044715f * x * x * x)); }
template <int CTRL> __device__ __forceinline__ float dpp_mov(float x) { return __builtin_bit_cast(float, __builtin_amdgcn_update_dpp(0, __builtin_bit_cast(int, x), CTRL, 0xf, 0xf, false)); }
__device__ __forceinline__ float red8(float x) { x += dpp_mov<0xB1>(x); x += dpp_mov<0x4E>(x); x += dpp_mov<0x141>(x); return x; }
__device__ __forceinline__ float red16(float x) { x += dpp_mov<0xB1>(x); x += dpp_mov<0x4E>(x); x += dpp_mov<0x141>(x); x += dpp_mov<0x140>(x); return x; }
__device__ __forceinline__ float wave_sum(float v) {
#pragma unroll
    for (int o = 32; o >= 1; o >>= 1) v += __shfl_xor(v, o, 64);
    return v;
}

__device__ __forceinline__ int lgdim() { int g = gridDim.x; asm volatile("" : "+s"(g)); return g; }
__device__ __forceinline__ int lbid() { int b = blockIdx.x; asm volatile("" : "+s"(b)); return b; }
__device__ __forceinline__ int ltid() { int t = threadIdx.x; asm volatile("" : "+v"(t)); return t; }
#define GD_ lgdim()
#define BI_ lbid()
namespace pg8 {
constexpr int BM = 256, BK = 64, HALF = 128, HTB = HALF * BK * 2, NXCD = 8, WGM = 8;
__device__ __forceinline__ int lds_byte(int r, int c) { const int st = (r >> 4) * 2 + (c >> 5), rr = r & 15, cc = c & 31, ob = rr * 64 + cc * 2; return st * 1024 + (ob ^ (((ob >> 9) & 1) << 5)); }
__device__ __forceinline__ void stage_rc(int b, int& R, int& C) { const int st = b / 1024, sb = b % 1024, swz = sb ^ (((sb >> 9) & 1) << 5); R = (st >> 1) * 16 + swz / 64; C = (st & 1) * 32 + (swz % 64) / 2; }
__device__ __forceinline__ int perm32(int rho) { const int n = rho >> 4, i = rho & 15; return 8 * (i >> 2) + 4 * n + (i & 3); }

struct Unit { int pm, pn, z, r0, rend, first; };
struct Gemm { const bf16_t* A; const bf16_t* Bt; int lda, ldb, K, nM, nN, nZ, zdiv; long zA1, zA2, zB1, zB2; int ksplit; long adelta; int ovl; int koffpn, koff; int pm0; };

struct Sched {
    int nM, nN, per, total, G, c, ovl, pm0;
    __device__ __forceinline__ void init(const Gemm& g, int G_, int c_) { nM = g.nM; nN = g.nN; per = nM * nN; total = per * g.nZ; G = G_; c = c_; ovl = g.ovl; pm0 = g.pm0; }
    __device__ __forceinline__ bool next(int i, Unit& u) const {
        const long L = (long)i * G + c; if (L >= total) return false;
        int w = (int)L; { const int q = total / NXCD, r = total % NXCD, xcd = w % NXCD, off = w / NXCD; w = (xcd < r ? xcd * (q + 1) : r * (q + 1) + (xcd - r) * q) + off; }
        u.z = w / per; w -= u.z * per;
        const int nig = WGM * nN, gid = w / nig, fm = gid * WGM, gsz = (nM - fm) < WGM ? (nM - fm) : WGM;
        u.pm = fm + ((w % nig) % gsz); u.pn = (w % nig) / gsz;
        u.pm += pm0;
        { const int b = u.pm / 33, j = u.pm - b * 33, r0o = b * SEQ_ + 254 * j - 2, eo = (b + 1) * SEQ_, ro = (r0o + BM < eo) ? r0o + BM : eo;
          const int r0 = ovl ? r0o : u.pm * BM, re = ovl ? ro : u.pm * BM + BM, fi = ovl ? (int)(j == 0) : 0; u.r0 = r0; u.rend = re; u.first = fi; }
        return true;
    }
};
__device__ __forceinline__ const char* unitA(const Gemm& g, const Unit& u) { return (const char*)(g.A + (long)(u.z / g.zdiv) * g.zA1 + (long)(u.z % g.zdiv) * g.zA2 + (long)u.r0 * g.lda + (u.pn >= g.koffpn ? g.koff : 0)); }
__device__ __forceinline__ const char* unitB(const Gemm& g, const Unit& u) { return (const char*)(g.Bt + (long)(u.z / g.zdiv) * g.zB1 + (long)(u.z % g.zdiv) * g.zB2 + (long)u.pn * BM * g.ldb + (u.pn >= g.koffpn ? g.koff : 0)); }

enum { OP_NONE = 0, OP_LORA1 = 2, OP_LORA2 = 3, OP_GELU = 4 };
struct EpiBfData { bf16_t* O; int ldc; int zdiv; long zO1, zO2; int split_cols; long split_stride; const float* p0; const float* p1; float scale; const float* ss; float* vs; LAS float* red; };
template <int OP> struct EpiBf : EpiBfData {
    static constexpr bool PERM = true, HAS_PF = false;
    __device__ __forceinline__ void operator()(const f32x4 (&acc)[2][2][4][2], const Unit& u, int wr, int wc, int fr, int fq) const {
        const int row0 = u.r0 + wr * 64 + fr; int colt = u.pn * BM; bf16_t* base = O + (long)(u.z / zdiv) * zO1 + (long)(u.z % zdiv) * zO2;
        if (split_cols) { const int t = colt / split_cols; base += (long)t * split_stride; colt -= t * split_cols; }
        const int col0 = colt + wc * 64 + 8 * fq, gcol0 = u.pn * BM + wc * 64 + 8 * fq;
        float rsv[8];
#pragma unroll
        for (int i = 0; i < 8; ++i) rsv[i] = 1024.f;
        if (OP == OP_NONE || OP == OP_GELU) { if (ss) {
#pragma unroll
            for (int i = 0; i < 8; ++i) { const f32x4 t = *(const f32x4*)(ss + (long)(row0 + (i >> 2) * HALF + (i & 3) * 16) * 4); rsv[i] = (t[0] + t[1]) + (t[2] + t[3]); } } }
#pragma unroll
        for (int ai = 0; ai < 2; ++ai)
#pragma unroll
            for (int m = 0; m < 4; ++m) {
                const int row = row0 + ai * HALF + m * 16;
                float rs = scale, t1 = 0.f, t2 = 0.f;
                if (OP == OP_NONE || OP == OP_GELU) { if (ss) rs *= rsqrtf(rsv[ai * 4 + m] * (1.f / 1024.f) + 1e-6f); }
#pragma unroll
                for (int bj = 0; bj < 2; ++bj) {
                    const int gc = gcol0 + bj * 32;
                    f32x4 q0 = {0.f, 0.f, 0.f, 0.f}, q1 = {0.f, 0.f, 0.f, 0.f};
                    if (OP == OP_LORA2) { if (gc < 1024) { q0 = *(const f32x4*)(p0 + gc); q1 = *(const f32x4*)(p0 + gc + 4); } else if (gc < 2048) { q0 = *(const f32x4*)(p1 + gc - 1024); q1 = *(const f32x4*)(p1 + gc - 1024 + 4); } }
                    bf16_t* rowp = base + (long)row * ldc + col0 + bj * 32;
                    f32x4 v0 = acc[ai][bj][m][0], v1 = acc[ai][bj][m][1];
                    if (OP == OP_NONE || OP == OP_GELU) { v0 = v0 * rs; v1 = v1 * rs; }
                    if (OP == OP_LORA1) {
                        if (gc < 64) { for (int e = 0; e < 4; ++e) { v0[e] = tanhf_(v0[e]); v1[e] = tanhf_(v1[e]); } }
                        else if (gc >= 128) { for (int e = 0; e < 4; ++e) { v0[e] = sigmoidf_(v0[e]); v1[e] = sigmoidf_(v1[e]); } }
                    }
                    if (OP == OP_LORA2) {
                        if (gc < 1024) { for (int e = 0; e < 4; ++e) { v0[e] = 0.6065306597f * sigmoidf_(v0[e] + q0[e]); v1[e] = 0.6065306597f * sigmoidf_(v1[e] + q1[e]); } }
                        else if (gc < 2048) { for (int e = 0; e < 4; ++e) { v0[e] = sigmoidf_(v0[e] + q0[e]); v1[e] = sigmoidf_(v1[e] + q1[e]); } }
                    }
                    if (OP == OP_GELU) { for (int e = 0; e < 4; ++e) { v0[e] = gelu_tanh(v0[e]); v1[e] = gelu_tanh(v1[e]); t1 += v0[e] + v1[e]; t2 += v0[e] * v0[e] + v1[e] * v1[e]; } }
                    u32x4 w; w.x = cvt_pk_bf16(v0[0], v0[1]); w.y = cvt_pk_bf16(v0[2], v0[3]); w.z = cvt_pk_bf16(v1[0], v1[1]); w.w = cvt_pk_bf16(v1[2], v1[3]);
                    *(u32x4*)rowp = w;
                }
                if (OP == OP_GELU) { if (vs && u.pn >= 4) { t1 += __shfl_xor(t1, 16, 64); t1 += __shfl_xor(t1, 32, 64); t2 += __shfl_xor(t2, 16, 64); t2 += __shfl_xor(t2, 32, 64);
                    if (fq == 0) { LAS float* d = red + ((ai * HALF + wr * 64 + m * 16 + fr) * 4 + wc) * 2; d[0] = t1; d[1] = t2; } } }
            }
        if (OP == OP_GELU) { if (vs && u.pn >= 4) {
            asm volatile("s_waitcnt lgkmcnt(0)" ::: "memory"); __builtin_amdgcn_s_barrier(); asm volatile("" ::: "memory");
            if (wc == 0 && fq == 0) {
#pragma unroll
                for (int ai = 0; ai < 2; ++ai)
#pragma unroll
                    for (int m = 0; m < 4; ++m) { const int rl = ai * HALF + wr * 64 + m * 16 + fr; const f32x4 a = *(const LAS f32x4*)(red + rl * 8), b = *(const LAS f32x4*)(red + rl * 8 + 4);
                        *(f32x2*)(vs + (long)(u.r0 + rl) * 8 + (u.pn - 4) * 2) = (f32x2){(a[0] + a[2]) + (b[0] + b[2]), (a[1] + a[3]) + (b[1] + b[3])}; }
            } } }
    }
};
struct EpiRes {
    static constexpr bool PERM = true, HAS_PF = false;
    const float* res32; bf16_t* xb; float* ss; int ldc; LAS float* red;
    __device__ __forceinline__ void operator()(const f32x4 (&acc)[2][2][4][2], const Unit& u, int wr, int wc, int fr, int fq) const {
        const int row0 = u.r0 + wr * 64 + fr, col0 = u.pn * BM + wc * 64 + 8 * fq;
#pragma unroll
        for (int ai = 0; ai < 2; ++ai)
#pragma unroll
            for (int m = 0; m < 4; ++m) {
                const int row = row0 + ai * HALF + m * 16;
                const long ro = (long)row * ldc + col0; float sq = 0.f;
#pragma unroll
                for (int bj = 0; bj < 2; ++bj) {
                    f32x4 r0, r1;
                    if (res32) { r0 = *(const f32x4*)(res32 + ro + bj * 32); r1 = *(const f32x4*)(res32 + ro + bj * 32 + 4); }
                    else { const u32x4 t = *(const u32x4*)(xb + ro + bj * 32); r0 = (f32x4){bf_lo(t.x), bf_hi(t.x), bf_lo(t.y), bf_hi(t.y)}; r1 = (f32x4){bf_lo(t.z), bf_hi(t.z), bf_lo(t.w), bf_hi(t.w)}; }
                    r0 = r0 + acc[ai][bj][m][0]; r1 = r1 + acc[ai][bj][m][1];
                    u32x4 w; w.x = cvt_pk_bf16(r0[0], r0[1]); w.y = cvt_pk_bf16(r0[2], r0[3]); w.z = cvt_pk_bf16(r1[0], r1[1]); w.w = cvt_pk_bf16(r1[2], r1[3]);
                    *(u32x4*)(xb + ro + bj * 32) = w;
                    sq += r0[0] * r0[0] + r0[1] * r0[1] + r0[2] * r0[2] + r0[3] * r0[3] + r1[0] * r1[0] + r1[1] * r1[1] + r1[2] * r1[2] + r1[3] * r1[3];
                }
                if (ss) { sq += __shfl_xor(sq, 16, 64); sq += __shfl_xor(sq, 32, 64); if (fq == 0) red[(ai * HALF + wr * 64 + m * 16 + fr) * 4 + wc] = sq; }
            }
        if (ss) {
            asm volatile("s_waitcnt lgkmcnt(0)" ::: "memory"); __builtin_amdgcn_s_barrier(); asm volatile("" ::: "memory");
            if (wc == 0 && fq == 0) {
#pragma unroll
                for (int ai = 0; ai < 2; ++ai)
#pragma unroll
                    for (int m = 0; m < 4; ++m) { const int rl = ai * HALF + wr * 64 + m * 16 + fr; const f32x4 r4 = *(const LAS f32x4*)(red + rl * 4);
                        ss[(long)(u.r0 + rl) * 4 + u.pn] = (r4[0] + r4[1]) + (r4[2] + r4[3]); }
            }
        }
    }
};
struct EpiConv {
    static constexpr bool PERM = true, HAS_PF = true;
    __device__ __forceinline__ void prefetch(const Unit& u, LAS unsigned char* lds, int wid, int lane) const {
        if (wid < 4) __builtin_amdgcn_global_load_lds((const unsigned*)(ss + (long)(u.r0 + wid * 64 + lane) * 4), (LAS unsigned*)(lds + EXTRA_OFF + 8192 + wid * 1024), 16, 0, 0);
    }
    bf16_t* H; const float* cw; const float* cb; const float* ss; LAS float* ex;
    __device__ __forceinline__ void operator()(f32x4 (&acc)[2][2][4][2], const Unit& u, int wr, int wc, int fr, int fq) const {
        const int rowb = u.r0 + wr * 64 + fr, colg = u.pn * HALF + wc * 32 + 8 * fq;
#pragma unroll
        for (int ai = 0; ai < 2; ++ai)
#pragma unroll
            for (int m = 0; m < 4; ++m) {
                const f32x4 st4 = *(const LAS f32x4*)(ex + 2048 + (wr * 64 + fr + ai * HALF + m * 16) * 4);   float rs = rsqrtf(((st4[0] + st4[1]) + (st4[2] + st4[3])) * (1.f / 1024.f) + 1e-6f);
                const bool zg = (u.first && ai == 0 && m == 0 && wr == 0 && fr < 2);
                acc[ai][1][m][0] = acc[ai][1][m][0] * rs; acc[ai][1][m][1] = acc[ai][1][m][1] * rs;
                if (zg) { acc[ai][0][m][0] = (f32x4){0.f, 0.f, 0.f, 0.f}; acc[ai][0][m][1] = (f32x4){0.f, 0.f, 0.f, 0.f}; }
                else { acc[ai][0][m][0] = acc[ai][0][m][0] * rs; acc[ai][0][m][1] = acc[ai][0][m][1] * rs; }
            }
        if (fr >= 14) {
#pragma unroll
            for (int ai = 0; ai < 2; ++ai) { LAS float* d = ex + ((((ai * 2 + wr) * 4 + wc) * 2 + (fr - 14)) * 32 + fq * 8); *(LAS f32x4*)d = acc[ai][0][3][0]; *(LAS f32x4*)(d + 4) = acc[ai][0][3][1]; }
        }
        f32x4 w0[2], w1[2], w2[2], bb[2];
#pragma unroll
        for (int n = 0; n < 2; ++n) { w0[n] = *(const f32x4*)(cw + colg + 4 * n); w1[n] = *(const f32x4*)(cw + FF_ + colg + 4 * n); w2[n] = *(const f32x4*)(cw + 2 * FF_ + colg + 4 * n); bb[n] = *(const f32x4*)(cb + colg + 4 * n); }
        asm volatile("s_waitcnt lgkmcnt(0)" ::: "memory"); __builtin_amdgcn_s_barrier(); asm volatile("" ::: "memory");
#pragma unroll
        for (int ai = 0; ai < 2; ++ai)
#pragma unroll
            for (int m = 0; m < 4; ++m) {
                const int row = rowb + ai * HALF + m * 16;
                u32x4 w;
                f32x4 P1[2] = {{0.f, 0.f, 0.f, 0.f}, {0.f, 0.f, 0.f, 0.f}}, P2[2] = {{0.f, 0.f, 0.f, 0.f}, {0.f, 0.f, 0.f, 0.f}};
                if (m == 0) { const int pblk = ai * 2 + wr - 1;
                    if (pblk >= 0) { const LAS float* s = ex + ((pblk * 4 + wc) * 2) * 32 + fq * 8; P2[0] = *(const LAS f32x4*)s; P2[1] = *(const LAS f32x4*)(s + 4); P1[0] = *(const LAS f32x4*)(s + 32); P1[1] = *(const LAS f32x4*)(s + 36); } }
#pragma unroll
                for (int n = 0; n < 2; ++n) {
                    float hh[4];
#pragma unroll
                    for (int i = 0; i < 4; ++i) {
                        const float g0 = acc[ai][0][m][n][i];
                        float o1, o2;
                        if (m > 0) { const float pv = acc[ai][0][m > 0 ? m - 1 : 0][n][i]; o1 = dpp_mov<0x121>(pv); o2 = dpp_mov<0x122>(pv); }
                        else { o1 = P1[n][i]; o2 = (fr == 0) ? P2[n][i] : P1[n][i]; }
                        const float up1 = __builtin_bit_cast(float, __builtin_amdgcn_update_dpp(__builtin_bit_cast(int, o1), __builtin_bit_cast(int, g0), 0x111, 0xf, 0xf, false));
                        const float up2 = __builtin_bit_cast(float, __builtin_amdgcn_update_dpp(__builtin_bit_cast(int, o2), __builtin_bit_cast(int, g0), 0x112, 0xf, 0xf, false));
                        const float cv = up2 * w0[n][i] + up1 * w1[n][i] + g0 * w2[n][i] + bb[n][i];
                        hh[i] = cv * sigmoidf_(cv) * acc[ai][1][m][n][i];
                    }
                    if (n == 0) { w.x = cvt_pk_bf16(hh[0], hh[1]); w.y = cvt_pk_bf16(hh[2], hh[3]); } else { w.z = cvt_pk_bf16(hh[0], hh[1]); w.w = cvt_pk_bf16(hh[2], hh[3]); }
                }
                if (row >= u.r0 + 2 && row < u.rend) *(u32x4*)(H + (long)row * FF_ + colg) = w;
            }
    }
};
struct EpiSoftmax {
    static constexpr bool PERM = true, HAS_PF = false;
    bf16_t* P; LAS float* red;
    __device__ __forceinline__ void operator()(f32x4 (&acc)[2][2][4][2], const Unit& u, int wr, int wc, int fr, int fq) const {
        float mx[2][4];
#pragma unroll
        for (int ai = 0; ai < 2; ++ai)
#pragma unroll
            for (int m = 0; m < 4; ++m) {
                float v = -3.0e38f;
#pragma unroll
                for (int bj = 0; bj < 2; ++bj)
#pragma unroll
                    for (int n = 0; n < 2; ++n)
#pragma unroll
                        for (int e = 0; e < 4; ++e) v = fmaxf(v, acc[ai][bj][m][n][e]);
                v = fmaxf(v, __shfl_xor(v, 16, 64)); v = fmaxf(v, __shfl_xor(v, 32, 64));
                if (fq == 0) red[(ai * HALF + wr * 64 + m * 16 + fr) * 4 + wc] = v;
                mx[ai][m] = v;
            }
        asm volatile("s_waitcnt lgkmcnt(0)" ::: "memory"); __builtin_amdgcn_s_barrier(); asm volatile("" ::: "memory");
#pragma unroll
        for (int ai = 0; ai < 2; ++ai)
#pragma unroll
            for (int m = 0; m < 4; ++m) {
                const f32x4 r4 = *(const LAS f32x4*)(red + (ai * HALF + wr * 64 + m * 16 + fr) * 4);
                const float M = fmaxf(fmaxf(r4[0], r4[1]), fmaxf(r4[2], r4[3]));
                float s = 0.f;
#pragma unroll
                for (int bj = 0; bj < 2; ++bj)
#pragma unroll
                    for (int n = 0; n < 2; ++n)
#pragma unroll
                        for (int e = 0; e < 4; ++e) { const float p = __expf(acc[ai][bj][m][n][e] - M); acc[ai][bj][m][n][e] = p; s += p; }
                s += __shfl_xor(s, 16, 64); s += __shfl_xor(s, 32, 64);
                if (fq == 0) red[1024 + (ai * HALF + wr * 64 + m * 16 + fr) * 4 + wc] = s;
            }
        asm volatile("s_waitcnt lgkmcnt(0)" ::: "memory"); __builtin_amdgcn_s_barrier(); asm volatile("" ::: "memory");
        const int b = u.z >> 2, h = u.z & 3;
        bf16_t* base = P + ((long)b * SEQ_ + u.r0 + wr * 64 + fr) * D_ + h * 256 + wc * 64 + 8 * fq;
#pragma unroll
        for (int ai = 0; ai < 2; ++ai)
#pragma unroll
            for (int m = 0; m < 4; ++m) {
                const f32x4 r4 = *(const LAS f32x4*)(red + 1024 + (ai * HALF + wr * 64 + m * 16 + fr) * 4);
                const float inv = 1.f / (r4[0] + r4[1] + r4[2] + r4[3]);
#pragma unroll
                for (int bj = 0; bj < 2; ++bj) {
                    const f32x4 v0 = acc[ai][bj][m][0] * inv, v1 = acc[ai][bj][m][1] * inv;
                    u32x4 w; w.x = cvt_pk_bf16(v0[0], v0[1]); w.y = cvt_pk_bf16(v0[2], v0[3]); w.z = cvt_pk_bf16(v1[0], v1[1]); w.w = cvt_pk_bf16(v1[2], v1[3]);
                    *(u32x4*)(base + (long)(ai * HALF + m * 16) * D_ + bj * 32) = w;
                }
            }
    }
};

template <class Epi> struct MakeEpi;
template <class Epi, bool SPLITA, class PT>
__device__ __forceinline__ void gemm_phase(LAS unsigned char* lds, const Gemm g, const PT& P, int step, int Gs = 0, int bi = 0) {
    const int tid = ltid(), wid = __builtin_amdgcn_readfirstlane(tid >> 6), lane = tid & 63, wr = wid >> 2, wc = wid & 3, fr = lane & 15, fq = lane >> 4;
    const int K = g.K, nt = K / BK;
    Sched S; if (Gs > 0) S.init(g, Gs, bi); else S.init(g, GD_, BI_);
    unsigned voffA[2], voffB[2];
#pragma unroll
    for (int i = 0; i < 2; ++i) { int R, C; stage_rc(tid * 16 + i * 8192, R, C); const int Rb = Epi::PERM ? (64 * (R >> 5) + perm32(R & 31)) : R;
        voffA[i] = (unsigned)(R * g.lda + C) * 2u; voffB[i] = (unsigned)(Rb * g.ldb + C) * 2u; }
    const size_t kstep = (size_t)(BK * 2);
    const size_t hstepA = (size_t)HALF * g.lda * 2, hstepB = (size_t)(Epi::PERM ? 32 : HALF) * g.ldb * 2;
    const unsigned ldsw = (unsigned)wid * 1024u;
    const int aoff = lds_byte(wr * 64 + fr, fq * 8), boff = lds_byte(wc * 32 + fr, fq * 8);
#define PG8_SA(b, h) (((b) * 2 + (h)) * HTB)
#define PG8_SB(b, h) ((4 + (b) * 2 + (h)) * HTB)
#define PG8_STAGE(bufoff, gbase, voff) do { _Pragma("unroll") for (int _i = 0; _i < 2; ++_i) \
        __builtin_amdgcn_global_load_lds((const unsigned*)((const char*)(gbase) + (voff)[_i]), (LAS unsigned*)(lds + (bufoff) + ldsw + _i * 8192), 16, 0, 0); } while (0)
#define PG8_LDA(dst, b, h) do { _Pragma("unroll") for (int m = 0; m < 4; ++m) _Pragma("unroll") for (int k = 0; k < 2; ++k) dst[m][k] = *(const LAS bf16x8*)(lds + PG8_SA(b, h) + aoff + m * 2048 + k * 1024); } while (0)
#define PG8_LDB(dst, b, h) do { _Pragma("unroll") for (int n = 0; n < 2; ++n) _Pragma("unroll") for (int k = 0; k < 2; ++k) dst[n][k] = *(const LAS bf16x8*)(lds + PG8_SB(b, h) + boff + n * 2048 + k * 1024); } while (0)
#define PG8_MMA(ai, bj, At, Bt) do { __builtin_amdgcn_s_setprio(1); _Pragma("unroll") for (int m = 0; m < 4; ++m) _Pragma("unroll") for (int n = 0; n < 2; ++n) _Pragma("unroll") for (int k = 0; k < 2; ++k) \
        acc[ai][bj][m][n] = __builtin_amdgcn_mfma_f32_16x16x32_bf16(Bt[n][k], At[m][k], acc[ai][bj][m][n], 0, 0, 0); __builtin_amdgcn_s_setprio(0); } while (0)
#define PG8_WAIT_V(n) asm volatile("s_waitcnt vmcnt(" #n ")" ::: "memory")
#define PG8_WAIT_L(n) asm volatile("s_waitcnt lgkmcnt(" #n ")" ::: "memory")
#define PG8_BAR __builtin_amdgcn_s_barrier()
#define PG8_SCHED __builtin_amdgcn_sched_barrier(0)
#define PG8_AK(base, t) ((base) + (size_t)(t) * kstep + ((SPLITA && (t) >= g.ksplit) ? g.adelta : 0l))
    Unit cur, nxt; int ui = 0;
    if (!S.next(0, cur)) return;
    f32x4 acc[2][2][4][2];
#pragma unroll
    for (int a = 0; a < 2; ++a)
#pragma unroll
        for (int b = 0; b < 2; ++b)
#pragma unroll
            for (int m = 0; m < 4; ++m)
#pragma unroll
                for (int n = 0; n < 2; ++n) acc[a][b][m][n] = (f32x4){0.f, 0.f, 0.f, 0.f};
    bf16x8 At[4][2], B0[2][2], B1[2][2];
    const char* cA = unitA(g, cur); const char* cB = unitB(g, cur);
    PG8_STAGE(PG8_SB(0, 0), cB, voffB); PG8_STAGE(PG8_SB(0, 1), cB + hstepB, voffB); PG8_STAGE(PG8_SA(0, 0), cA, voffA); PG8_STAGE(PG8_SA(0, 1), cA + hstepA, voffA);
    if (wr == 1) PG8_BAR;
    PG8_WAIT_V(2); PG8_BAR;
    PG8_STAGE(PG8_SB(1, 0), cB + kstep, voffB); PG8_STAGE(PG8_SA(1, 0), cA + kstep, voffA); PG8_STAGE(PG8_SB(1, 1), cB + hstepB + kstep, voffB);
    PG8_WAIT_V(6); PG8_BAR;
    for (;;) {
        const bool has_next = S.next(ui + 1, nxt);
        const char* nA = has_next ? unitA(g, nxt) : cA; const char* nB = has_next ? unitB(g, nxt) : cB;
        if constexpr (Epi::HAS_PF) { int st3 = step; asm volatile("" : "+s"(st3)); const Epi Ep = MakeEpi<Epi>::make(P, st3, lds); Ep.prefetch(cur, lds, wid, lane); }
        for (int t = 0; t < nt; t += 2) {
            const bool last = (t == nt - 2);
            const char* a1 = PG8_AK(cA, t + 1);
            const char* a2 = last ? nA : PG8_AK(cA, t + 2); const char* b2 = last ? nB : cB + (size_t)(t + 2) * kstep;
            const char* a3 = last ? nA + kstep : PG8_AK(cA, t + 3); const char* b3 = b2 + kstep;
            PG8_LDB(B0, 0, 0); PG8_LDB(B1, 0, 1); PG8_SCHED; PG8_LDA(At, 0, 0); PG8_STAGE(PG8_SA(1, 1), a1 + hstepA, voffA);
            PG8_WAIT_V(8); PG8_WAIT_L(0); PG8_BAR; PG8_MMA(0, 0, At, B0); PG8_MMA(0, 1, At, B1); PG8_BAR; PG8_SCHED;
            PG8_LDA(At, 0, 1); PG8_STAGE(PG8_SB(0, 0), b2, voffB); PG8_STAGE(PG8_SB(0, 1), b2 + hstepB, voffB); PG8_STAGE(PG8_SA(0, 0), a2, voffA);
            PG8_WAIT_V(8); PG8_WAIT_L(0); PG8_BAR; PG8_MMA(1, 0, At, B0); PG8_MMA(1, 1, At, B1); PG8_BAR; PG8_SCHED;
            PG8_LDB(B0, 1, 0); PG8_LDB(B1, 1, 1); PG8_SCHED; PG8_LDA(At, 1, 0); PG8_STAGE(PG8_SA(0, 1), a2 + hstepA, voffA);
            PG8_WAIT_V(8); PG8_WAIT_L(0); PG8_BAR; PG8_MMA(0, 0, At, B0); PG8_MMA(0, 1, At, B1); PG8_BAR; PG8_SCHED;
            PG8_LDA(At, 1, 1); PG8_STAGE(PG8_SB(1, 0), b3, voffB); PG8_STAGE(PG8_SB(1, 1), b3 + hstepB, voffB); PG8_STAGE(PG8_SA(1, 0), a3, voffA);
            PG8_WAIT_V(8); PG8_WAIT_L(0); PG8_BAR; PG8_MMA(1, 0, At, B0); PG8_MMA(1, 1, At, B1); PG8_BAR; PG8_SCHED;
        }
        if (wr == 0) PG8_BAR;
        { int st2 = step; asm volatile("" : "+s"(st2)); const Epi E = MakeEpi<Epi>::make(P, st2, lds); E(acc, cur, wr, wc, fr, fq); }
        if (!has_next) break;
#pragma unroll
        for (int a = 0; a < 2; ++a)
#pragma unroll
            for (int b = 0; b < 2; ++b)
#pragma unroll
                for (int m = 0; m < 4; ++m)
#pragma unroll
                    for (int n = 0; n < 2; ++n) acc[a][b][m][n] = (f32x4){0.f, 0.f, 0.f, 0.f};
        cur = nxt; cA = nA; cB = nB; ++ui;
        if (wr == 1) PG8_BAR;
    }
    PG8_WAIT_V(0);
    PG8_BAR;
#undef PG8_SA
#undef PG8_SB
#undef PG8_STAGE
#undef PG8_LDA
#undef PG8_LDB
#undef PG8_MMA
#undef PG8_WAIT_V
#undef PG8_WAIT_L
#undef PG8_BAR
#undef PG8_SCHED
#undef PG8_AK
}
}

struct Params { const float* in[36]; float* out; unsigned char* ws; int ph_lo, ph_hi; };
enum { I_X = 0, I_MEM, I_NMIX, I_NMEM, I_NFFN, I_NFIN, I_MEMNORM, I_MU, I_WRKV, I_W0, I_W1, I_W2, I_A0, I_A1, I_A2, I_G1, I_G2, I_KK, I_KA, I_RK, I_LNXG, I_LNXB, I_RWO,
       I_GIN, I_GLNG, I_GLNB, I_GWS, I_GBS, I_GOUT, I_CAQ, I_CAKV, I_CAO, I_UP, I_CONVW, I_CONVB, I_DOWN };

__device__ __forceinline__ bf16_t* wsW(const Params& p, size_t eoff) { return (bf16_t*)p.ws + eoff; }
__device__ __forceinline__ bf16_t* slot(const Params& p, int i) { return (bf16_t*)(p.ws + WS_BUF + (size_t)i * SLOT); }

__device__ __forceinline__ void tr_job(const float* src, int K, int N, bf16_t* dst, int ldt, int& gbase, LAS float* tile, const float* rowscale = nullptr, int upmap = 0, int bi = -1, int Gs = 0) {
    const int tid = ltid(), ntn = N / 64, nt = (K / 64) * ntn, G = (bi >= 0) ? Gs : GD_; if (bi < 0) bi = BI_;
    int g = gbase + ((bi - gbase) % G + G) % G;
    for (; g < gbase + nt; g += G) {
        const int ti = g - gbase, k0 = (ti / ntn) * 64, n0 = (ti % ntn) * 64;
        __syncthreads();
        { const int kk = tid >> 4, n4 = (tid & 15) * 4;
#pragma unroll
          for (int h = 0; h < 2; ++h) { f32x4 v = *(const f32x4*)(src + (size_t)(k0 + kk + h * 32) * N + n0 + n4); if (rowscale) v = v * rowscale[k0 + kk + h * 32];
              LAS float* d = tile + (kk + h * 32) * 65 + n4; d[0] = v[0]; d[1] = v[1]; d[2] = v[2]; d[3] = v[3]; } }
        __syncthreads();
        { const int nn = tid >> 3, k8 = (tid & 7) * 8; float v[8];
#pragma unroll
          for (int j = 0; j < 8; ++j) v[j] = tile[(k8 + j) * 65 + nn];
          u32x4 w; w.x = cvt_pk_bf16(v[0], v[1]); w.y = cvt_pk_bf16(v[2], v[3]); w.z = cvt_pk_bf16(v[4], v[5]); w.w = cvt_pk_bf16(v[6], v[7]);
          int dr = n0 + nn; if (upmap) { const int nv = (n0 < FF_) ? n0 : n0 - FF_; dr = 256 * (nv / 128) + 2 * (nv % 128) + ((n0 < FF_) ? 0 : 32) + nn + ((nn >= 32) ? 32 : 0); }
          *(u32x4*)(dst + (size_t)dr * ldt + k0 + k8) = w; }
    }
    gbase += nt;
}
__device__ __forceinline__ unsigned short bf1(float v) { return (unsigned short)(cvt_pk_bf16(v, 0.f) & 0xffffu); }

__device__ __forceinline__ void phase_convert_late(const Params& p, LAS unsigned char* lds, int bi, int Gs) {
    LAS float* tile = (LAS float*)lds;
    int gb = 0;
    tr_job(p.in[I_GIN], 1024, 2048, wsW(p, W_GIN), 1024, gb, tile, p.in[I_NMIX] + 1024, 0, bi, Gs);
    tr_job(p.in[I_GOUT], 1024, 1024, wsW(p, W_GOUT), 1024, gb, tile, nullptr, 0, bi, Gs);
    for (int l = 0; l < 2; ++l) {
        tr_job(p.in[I_CAQ] + (size_t)l * Mi, 1024, 1024, wsW(p, W_CAQ + l * Mi), 1024, gb, tile, p.in[I_NMEM] + l * 1024, 0, bi, Gs);
        tr_job(p.in[I_CAO] + (size_t)l * Mi, 1024, 1024, wsW(p, W_CAO + l * Mi), 1024, gb, tile, nullptr, 0, bi, Gs);
        tr_job(p.in[I_UP] + (size_t)l * 5632 * 1024, 1024, 5632, wsW(p, W_UP + (size_t)l * 5632 * 1024), 1024, gb, tile, p.in[I_NFFN] + l * 1024, 1, bi, Gs);
        tr_job(p.in[I_DOWN] + (size_t)l * 2816 * 1024, 2816, 1024, wsW(p, W_DOWN + (size_t)l * 2816 * 1024), 2816, gb, tile, nullptr, 0, bi, Gs);
    }
    const int tid0 = ltid();
    for (int idx = bi * 512 + tid0; idx < 16 * 128 * 128; idx += Gs * 512) {
        const int t = (idx >> 7) & 127, s = idx & 127;
        wsW(p, W_GS)[idx] = bf1(s <= t ? p.in[I_GWS][idx] : 0.f);
    }
}
__device__ __forceinline__ void phase_prologue(const Params& p, LAS unsigned char* lds) {
    LAS float* tile = (LAS float*)lds;
    int gb = 0;
    for (int j = 0; j < 3; ++j) tr_job(p.in[I_WRKV] + (size_t)j * Mi, 1024, 1024, wsW(p, W_RKV + j * Mi), 1024, gb, tile);
    tr_job(p.in[I_RWO], 1024, 1024, wsW(p, W_RWO), 1024, gb, tile);
    for (int l = 0; l < 2; ++l) tr_job(p.in[I_CAKV] + (size_t)l * 2 * Mi, 1024, 2048, wsW(p, W_CAKV + l * 2 * Mi), 1024, gb, tile);
    const int tid0 = ltid(); const int gtid = BI_ * 512 + tid0, gth = GD_ * 512;
    for (int idx = gtid; idx < 256 * 2048; idx += gth) {
        const int n = idx >> 11, k = idx & 2047, kk = k & 1023;
        const float* src; int nn, Ns, mi;
        if (n < 64) { src = p.in[I_W1]; nn = n; Ns = 64; mi = 1; } else if (n < 128) { src = p.in[I_A1]; nn = n - 64; Ns = 64; mi = 4; } else { src = p.in[I_G1]; nn = n - 128; Ns = 128; mi = 5; }
        float v = src[kk * Ns + nn]; if (k >= 1024) v *= (p.in[I_MU][mi * 1024 + kk] - p.in[I_MU][kk]);
        wsW(p, W_L1)[idx] = bf1(v);
    }
    for (int idx = gtid; idx < 3072 * 256; idx += gth) {
        const int n = idx >> 8, k = idx & 255; float v = 0.f;
        if (n < 1024) { if (k < 64) v = p.in[I_W2][k * 1024 + n]; }
        else if (n < 2048) { if (k >= 64 && k < 128) v = p.in[I_A2][(k - 64) * 1024 + n - 1024]; }
        else { if (k >= 128) v = p.in[I_G2][(k - 128) * 1024 + n - 2048]; }
        wsW(p, W_L2)[idx] = bf1(v);
    }
    const int wave = tid0 >> 6, lane = tid0 & 63;
    for (int row = BI_ * 8 + wave; row < 2048; row += GD_ * 8) {
        const float* xr = p.in[I_MEM] + (size_t)row * 1024; f32x4 v[4]; float ss = 0.f;
#pragma unroll
        for (int i = 0; i < 4; ++i) { v[i] = *(const f32x4*)(xr + i * 256 + lane * 4); ss += v[i][0] * v[i][0] + v[i][1] * v[i][1] + v[i][2] * v[i][2] + v[i][3] * v[i][3]; }
        ss = wave_sum(ss); const float rs = rsqrtf(ss * (1.f / 1024.f) + 1e-6f);
        bf16_t* o = (bf16_t*)(p.ws + WS_MEMN) + (size_t)row * 1024;
#pragma unroll
        for (int i = 0; i < 4; ++i) { const f32x4 g = *(const f32x4*)(p.in[I_MEMNORM] + i * 256 + lane * 4);
            u32x2 w; w.x = cvt_pk_bf16(v[i][0] * rs * g[0], v[i][1] * rs * g[1]); w.y = cvt_pk_bf16(v[i][2] * rs * g[2], v[i][3] * rs * g[3]);
            *(u32x2*)(o + i * 256 + lane * 4) = w; }
    }
}

__device__ __forceinline__ void phase_rms(const float* x, const float* gain, bf16_t* out) {
    const int tid0 = ltid(); const int wave = tid0 >> 6, lane = tid0 & 63;
    f32x4 g[4];
#pragma unroll
    for (int i = 0; i < 4; ++i) g[i] = *(const f32x4*)(gain + i * 256 + lane * 4);
    for (int row = BI_ * 8 + wave; row < T_; row += GD_ * 8) {
        const float* xr = x + (size_t)row * 1024; f32x4 v[4]; float ss = 0.f;
#pragma unroll
        for (int i = 0; i < 4; ++i) { v[i] = *(const f32x4*)(xr + i * 256 + lane * 4); ss += v[i][0] * v[i][0] + v[i][1] * v[i][1] + v[i][2] * v[i][2] + v[i][3] * v[i][3]; }
        ss = wave_sum(ss); const float rs = rsqrtf(ss * (1.f / 1024.f) + 1e-6f);
        bf16_t* o = out + (size_t)row * 1024;
#pragma unroll
        for (int i = 0; i < 4; ++i) { u32x2 w; w.x = cvt_pk_bf16(v[i][0] * rs * g[i][0], v[i][1] * rs * g[i][1]); w.y = cvt_pk_bf16(v[i][2] * rs * g[i][2], v[i][3] * rs * g[i][3]);
            *(u32x2*)(o + i * 256 + lane * 4) = w; }
    }
}
__device__ __forceinline__ void phase_final(const bf16_t* xb, float* out, const float* gain) {
    const int tid0 = ltid(); const int wave = tid0 >> 6, lane = tid0 & 63;
    f32x4 g[4];
#pragma unroll
    for (int i = 0; i < 4; ++i) g[i] = *(const f32x4*)(gain + i * 256 + lane * 4);
    for (int row = (BI_ * 8 + wave) * 2; row < T_; row += GD_ * 16) {
        u32x2 t[2][4];
#pragma unroll
        for (int q = 0; q < 2; ++q)
#pragma unroll
            for (int i = 0; i < 4; ++i) t[q][i] = *(const u32x2*)(xb + (size_t)(row + q) * 1024 + i * 256 + lane * 4);
#pragma unroll
        for (int q = 0; q < 2; ++q) {
            f32x4 v[4]; float ss = 0.f;
#pragma unroll
            for (int i = 0; i < 4; ++i) { v[i] = (f32x4){bf_lo(t[q][i].x), bf_hi(t[q][i].x), bf_lo(t[q][i].y), bf_hi(t[q][i].y)}; ss += v[i][0] * v[i][0] + v[i][1] * v[i][1] + v[i][2] * v[i][2] + v[i][3] * v[i][3]; }
            ss = wave_sum(ss); const float rs = rsqrtf(ss * (1.f / 1024.f) + 1e-6f);
#pragma unroll
            for (int i = 0; i < 4; ++i) *(f32x4*)(out + (size_t)(row + q) * 1024 + i * 256 + lane * 4) = v[i] * rs * g[i];
        }
    }
}
__device__ __forceinline__ void phase_r0(const Params& p) {
    const int tid0 = ltid(); const int wave = tid0 >> 6, lane = tid0 & 63;
    const float* x = p.in[I_X]; const float* gain = p.in[I_NMIX]; const float* mu = p.in[I_MU];
    bf16_t* DX = slot(p, 1); bf16_t* XR = slot(p, 2); bf16_t* XK = slot(p, 3); bf16_t* XV = slot(p, 4);
    f32x4 gn[4], mr[4], mk[4], mv[4];
#pragma unroll
    for (int i = 0; i < 4; ++i) { const int c = i * 256 + lane * 4; gn[i] = *(const f32x4*)(gain + c); mr[i] = *(const f32x4*)(mu + c); mk[i] = *(const f32x4*)(mu + 2 * 1024 + c); mv[i] = *(const f32x4*)(mu + 3 * 1024 + c); }
    for (int task = BI_ * 8 + wave; task < T_ / 32; task += GD_ * 8) {
        const int t0 = task * 32;
f32x4 hp[4];
        if ((t0 & (SEQ_ - 1)) == 0) { for (int i = 0; i < 4; ++i) hp[i] = (f32x4){0.f, 0.f, 0.f, 0.f}; }
        else {
            const float* xr = x + (size_t)(t0 - 1) * 1024; float ss = 0.f;
#pragma unroll
            for (int i = 0; i < 4; ++i) { hp[i] = *(const f32x4*)(xr + i * 256 + lane * 4); ss += hp[i][0] * hp[i][0] + hp[i][1] * hp[i][1] + hp[i][2] * hp[i][2] + hp[i][3] * hp[i][3]; }
            ss = wave_sum(ss); const float rs = rsqrtf(ss * (1.f / 1024.f) + 1e-6f);
#pragma unroll
            for (int i = 0; i < 4; ++i) hp[i] = hp[i] * rs * gn[i];
        }
        f32x4 vn[4];
#pragma unroll
        for (int i = 0; i < 4; ++i) vn[i] = *(const f32x4*)(x + (size_t)t0 * 1024 + i * 256 + lane * 4);
        for (int r = 0; r < 32; ++r) {
            const size_t ro = (size_t)(t0 + r) * 1024; f32x4 v[4]; float ss = 0.f;
#pragma unroll
            for (int i = 0; i < 4; ++i) { v[i] = vn[i]; ss += v[i][0] * v[i][0] + v[i][1] * v[i][1] + v[i][2] * v[i][2] + v[i][3] * v[i][3]; }
            if (r + 1 < 32) {
#pragma unroll
                for (int i = 0; i < 4; ++i) vn[i] = *(const f32x4*)(x + ro + 1024 + i * 256 + lane * 4);
            }
            ss = wave_sum(ss); const float rs = rsqrtf(ss * (1.f / 1024.f) + 1e-6f);
#pragma unroll
            for (int i = 0; i < 4; ++i) {
                const int c = i * 256 + lane * 4;
                const f32x4 h = v[i] * rs * gn[i];
                const f32x4 dx = hp[i] - h; hp[i] = h;
                const f32x4 a = h + dx * mr[i], b = h + dx * mk[i], d = h + dx * mv[i];
                u32x2 w;
                w.x = cvt_pk_bf16(dx[0], dx[1]); w.y = cvt_pk_bf16(dx[2], dx[3]); *(u32x2*)(DX + ro + c) = w;
                w.x = cvt_pk_bf16(a[0], a[1]); w.y = cvt_pk_bf16(a[2], a[3]); *(u32x2*)(XR + ro + c) = w;
                w.x = cvt_pk_bf16(b[0], b[1]); w.y = cvt_pk_bf16(b[2], b[3]); *(u32x2*)(XK + ro + c) = w;
                w.x = cvt_pk_bf16(d[0], d[1]); w.y = cvt_pk_bf16(d[2], d[3]); *(u32x2*)(XV + ro + c) = w;
            }
        }
    }
}

typedef short s16x4 __attribute__((ext_vector_type(4)));
typedef __bf16 bf16x2_t __attribute__((ext_vector_type(2)));
__device__ __forceinline__ unsigned cvt2(float lo, float hi) { f32x2 v = {lo, hi}; bf16x2_t b = __builtin_convertvector(v, bf16x2_t); return __builtin_bit_cast(unsigned, b); }
__device__ __forceinline__ s16x4 cvt4(f32x4 x) { u32x2 q = {cvt2(x[0], x[1]), cvt2(x[2], x[3])}; return __builtin_bit_cast(s16x4, q); }
__device__ __forceinline__ unsigned short bfs(float x) { return (unsigned short)(cvt2(x, 0.f) & 0xffffu); }
__device__ __forceinline__ float bfl(unsigned short x) { return __builtin_bit_cast(float, (unsigned)x << 16); }
#define MFMA16(a, b, c) __builtin_amdgcn_mfma_f32_16x16x16bf16_1k((a), (b), (c), 0, 0, 0)
#define MFMA32(a, b, c) __builtin_amdgcn_mfma_f32_16x16x32_bf16((a), (b), (c), 0, 0, 0)
constexpr int RS_ = 144, SM_ = 40;
constexpr int PK_QH = 0, PK_RT = 2304, PK_NH = 4608, PK_MBN = 5248, PK_MK = 5888, PK_BPN = 6528, PK_KP = 8672, PK_VT = 10816, PK_DC = 12960, PK_BYTES = 13312;
constexpr int SCR_QM = 0, SCR_BM = 2304, SCR_KM = 4608, SCR_QT = 6912, SCR_BYTES = 9216, SCAN_SCR_OFF = 8 * PK_BYTES;
static_assert(SCAN_SCR_OFF + 4 * SCR_BYTES + 768 <= LDS_BYTES - 64, "scan LDS");

struct ScanRaw { u32x4 r[2], e[2], k[2], v[2], a[2]; };
__device__ __forceinline__ void scan_load(ScanRaw& x, const bf16_t* Rb, const bf16_t* Wb, const bf16_t* Kb, const bf16_t* Vb, const bf16_t* Ab, size_t base, int lane) {
    const size_t o = base + (size_t)(lane >> 2) * 1024 + (lane & 3) * 16;
#pragma unroll
    for (int q = 0; q < 2; ++q) { x.r[q] = *(const u32x4*)(Rb + o + 8 * q); x.e[q] = *(const u32x4*)(Wb + o + 8 * q); x.k[q] = *(const u32x4*)(Kb + o + 8 * q); x.v[q] = *(const u32x4*)(Vb + o + 8 * q); x.a[q] = *(const u32x4*)(Ab + o + 8 * q); }
}
__device__ __forceinline__ void unpack16(const u32x4 (&u)[2], float (&f)[16]) {
#pragma unroll
    for (int q = 0; q < 2; ++q) { f[8 * q] = bf_lo(u[q].x); f[8 * q + 1] = bf_hi(u[q].x); f[8 * q + 2] = bf_lo(u[q].y); f[8 * q + 3] = bf_hi(u[q].y); f[8 * q + 4] = bf_lo(u[q].z); f[8 * q + 5] = bf_hi(u[q].z); f[8 * q + 6] = bf_lo(u[q].w); f[8 * q + 7] = bf_hi(u[q].w); }
}
__device__ __forceinline__ void st_row16(LAS unsigned char* dst, const float (&t)[16]) {
    u32x4 w0, w1; w0.x = cvt2(t[0], t[1]); w0.y = cvt2(t[2], t[3]); w0.z = cvt2(t[4], t[5]); w0.w = cvt2(t[6], t[7]); w1.x = cvt2(t[8], t[9]); w1.y = cvt2(t[10], t[11]); w1.z = cvt2(t[12], t[13]); w1.w = cvt2(t[14], t[15]);
    *(LAS u32x4*)dst = w0; *(LAS u32x4*)(dst + 16) = w1;
}
__device__ __forceinline__ f32x4 unpk4(const u32x4 (&u)[2], int q) { const unsigned lo = (q & 1) ? u[q >> 1].z : u[q >> 1].x, hi = (q & 1) ? u[q >> 1].w : u[q >> 1].y; return (f32x4){bf_lo(lo), bf_hi(lo), bf_lo(hi), bf_hi(hi)}; }
__device__ __forceinline__ void scan_produce(const ScanRaw& x, LAS unsigned char* pkg, LAS unsigned char* scr, int lane, const LAS float* kkg, const LAS float* kag, const LAS float* rkg, float* bon) {
    const int fr = lane & 15, g = lane >> 4, i = lane >> 2, c0 = (lane & 3) * 16;
    LAS float* cs = (LAS float*)scr;
    cs[lane] = 0.f;
#pragma unroll
    for (int q = 0; q < 4; ++q) *(LAS f32x4*)(cs + (i + 1) * 68 + c0 + 4 * q) = unpk4(x.e, q) * 1.4426950408889634f;
    asm volatile("" ::: "memory");
    { float t[16];
#pragma unroll
      for (int j = 0; j < 16; ++j) t[j] = cs[(j + 1) * 68 + lane];
#pragma unroll
      for (int j = 1; j < 16; ++j) t[j] += t[j - 1];
#pragma unroll
      for (int j = 0; j < 16; ++j) cs[(j + 1) * 68 + lane] = t[j]; }
    asm volatile("" ::: "memory");
    float ss = 0.f;
#pragma unroll
    for (int q = 0; q < 4; ++q) { const f32x4 kkv = unpk4(x.k, q) * *(const LAS f32x4*)(kkg + c0 + 4 * q); ss += kkv[0] * kkv[0] + kkv[1] * kkv[1] + kkv[2] * kkv[2] + kkv[3] * kkv[3]; }
    ss += dpp_mov<0xB1>(ss); ss += dpp_mov<0x4E>(ss);
    const float inv = 1.f / fmaxf(sqrtf(ss), 1e-12f);
    f32x4 cu[4], cm[4], cC[4]; float bsum = 0.f;
#pragma unroll
    for (int q = 0; q < 4; ++q) { cu[q] = *(const LAS f32x4*)(cs + (i + 1) * 68 + c0 + 4 * q); cm[q] = *(const LAS f32x4*)(cs + i * 68 + c0 + 4 * q); cC[q] = *(const LAS f32x4*)(cs + 16 * 68 + c0 + 4 * q); }
    asm volatile("s_waitcnt lgkmcnt(0)" ::: "memory");
#pragma unroll
    for (int q = 0; q < 4; ++q) {
        const f32x4 k4 = unpk4(x.k, q), a4 = unpk4(x.a, q), r4 = unpk4(x.r, q), v4 = unpk4(x.v, q);
        const f32x4 kkp4 = *(const LAS f32x4*)(kkg + c0 + 4 * q), kap4 = *(const LAS f32x4*)(kag + c0 + 4 * q), rk4 = *(const LAS f32x4*)(rkg + c0 + 4 * q);
        float qv[4], btv[4], ktv[4], rtv[4], bpv[4], kpv[4];
#pragma unroll
        for (int s = 0; s < 4; ++s) {
            const float D = __builtin_amdgcn_exp2f(-cu[q][s]), Dm = __builtin_amdgcn_exp2f(-cm[q][s]), iD = __builtin_amdgcn_exp2f(cu[q][s]), DCr = __builtin_amdgcn_exp2f(cu[q][s] - cC[q][s]);
            const float kkv = k4[s] * kkp4[s] * inv, bbv = kkv * a4[s], k2 = k4[s] * (1.f + (a4[s] - 1.f) * kap4[s]);
            qv[s] = kkv * Dm; btv[s] = bbv * iD; ktv[s] = k2 * iD; rtv[s] = r4[s] * D; bpv[s] = -(bbv * DCr); kpv[s] = k2 * DCr; bsum += r4[s] * k2 * rk4[s];
            if (i == 15) *(LAS float*)(pkg + PK_DC + (c0 + 4 * q + s) * 4) = D;
            const int o = (c0 + 4 * q + s) * 32 + (lane & 3) * 32 + i * 2;
            *(LAS unsigned short*)(scr + SCR_QT + o) = bfs(qv[s]); *(LAS unsigned short*)(pkg + PK_VT + o) = bfs(v4[s]);
            *(LAS unsigned short*)(pkg + PK_BPN + o) = bfs(bpv[s]); *(LAS unsigned short*)(pkg + PK_KP + o) = bfs(kpv[s]);
        }
        const int ro = i * RS_ + (c0 + 4 * q) * 2;
        *(LAS u32x2*)(scr + SCR_QM + ro) = (u32x2){cvt2(qv[0], qv[1]), cvt2(qv[2], qv[3])}; *(LAS u32x2*)(scr + SCR_BM + ro) = (u32x2){cvt2(btv[0], btv[1]), cvt2(btv[2], btv[3])};
        *(LAS u32x2*)(scr + SCR_KM + ro) = (u32x2){cvt2(ktv[0], ktv[1]), cvt2(ktv[2], ktv[3])}; *(LAS u32x2*)(pkg + PK_RT + ro) = (u32x2){cvt2(rtv[0], rtv[1]), cvt2(rtv[2], rtv[3])};
    }
    bsum += dpp_mov<0xB1>(bsum); bsum += dpp_mov<0x4E>(bsum);
    if ((lane & 3) == 0) bon[i * 16] = bsum;
    asm volatile("" ::: "memory");
    const f32x4 z4 = {0.f, 0.f, 0.f, 0.f};
    f32x4 L = z4, LT = z4, NkT = z4, MbT = z4, MkT = z4;
#pragma unroll
    for (int kb = 0; kb < 2; ++kb) {
        const int fo = fr * RS_ + kb * 64 + g * 16;
        const bf16x8 fq = *(const LAS bf16x8*)(scr + SCR_QM + fo), fb = *(const LAS bf16x8*)(scr + SCR_BM + fo), fk = *(const LAS bf16x8*)(scr + SCR_KM + fo), frt = *(const LAS bf16x8*)(pkg + PK_RT + fo);
        L = MFMA32(fq, fb, L); LT = MFMA32(fb, fq, LT); NkT = MFMA32(fq, fk, NkT); MbT = MFMA32(frt, fb, MbT); MkT = MFMA32(frt, fk, MkT);
    }
    f32x4 I4;
#pragma unroll
    for (int jj = 0; jj < 4; ++jj) { const int row = 4 * g + jj;
        I4[jj] = (row == fr) ? 1.f : 0.f;
        L[jj] = (fr < row) ? L[jj] : 0.f; LT[jj] = (row < fr) ? LT[jj] : 0.f; NkT[jj] = (fr < row) ? NkT[jj] : 0.f;
        MbT[jj] = (fr <= row) ? -MbT[jj] : 0.f; MkT[jj] = (fr <= row) ? MkT[jj] : 0.f; }
    const s16x4 Lb = cvt4(L), LTb = cvt4(LT);
    const f32x4 L2 = MFMA16(LTb, Lb, z4), L2T = MFMA16(Lb, LTb, z4);
    const f32x4 X1T = I4 - LT;
    const f32x4 X2T = MFMA16(cvt4(I4 + L2), cvt4(X1T), z4);
    const s16x4 L2b = cvt4(L2), L2Tb = cvt4(L2T);
    const f32x4 L4 = MFMA16(L2Tb, L2b, z4), L4T = MFMA16(L2b, L2Tb, z4);
    const f32x4 X3T = MFMA16(cvt4(I4 + L4), cvt4(X2T), z4);
    const f32x4 L8 = MFMA16(cvt4(L4T), cvt4(L4), z4);
    const f32x4 X4T = MFMA16(cvt4(I4 + L8), cvt4(X3T), z4);
    const s16x4 TA = cvt4(X4T);
    const f32x4 Nh = MFMA16(TA, cvt4(NkT), z4);
#pragma unroll
    for (int kb = 0; kb < 4; ++kb) {
        const s16x4 qf = *(const LAS s16x4*)(scr + SCR_QT + (16 * kb + fr) * 32 + kb * 32 + g * 8);
        const f32x4 Qh = MFMA16(TA, qf, z4);
#pragma unroll
        for (int jj = 0; jj < 4; ++jj) *(LAS unsigned short*)(pkg + PK_QH + (4 * g + jj) * RS_ + (16 * kb + fr) * 2) = bfs(Qh[jj]);
    }
#pragma unroll
    for (int jj = 0; jj < 4; ++jj) { const int o = (4 * g + jj) * SM_ + fr * 2;
        *(LAS unsigned short*)(pkg + PK_NH + o) = bfs(Nh[jj]); *(LAS unsigned short*)(pkg + PK_MBN + o) = bfs(MbT[jj]); *(LAS unsigned short*)(pkg + PK_MK + o) = bfs(MkT[jj]); }
}

__device__ __forceinline__ void phase_scan(const Params& p, LAS unsigned char* lds) {
    const int tid = ltid(), wave = tid >> 6, lane = tid & 63, fr = lane & 15, g = lane >> 4;
    const bf16_t* Rb = slot(p, 5); const bf16_t* Kb = slot(p, 6); const bf16_t* Vb = (const bf16_t*)p.out;
    const bf16_t* Wb = slot(p, 2); const bf16_t* Ab = slot(p, 3);
    bf16_t* Ob = slot(p, 0);
    for (int unit = BI_; unit < 128; unit += GD_) {
        const int b = unit >> 4, h = unit & 15, pw = wave & 3;
        LAS float* par = (LAS float*)(lds + SCAN_SCR_OFF + 4 * SCR_BYTES);
        const LAS float* kkg = par; const LAS float* kag = par + 64; const LAS float* rkg = par + 128;
        float* bong = (float*)(p.ws + WS_BON) + ((size_t)b * SEQ_) * 16 + h;
        ScanRaw cur, nxt;
        const size_t hbase = ((size_t)b * SEQ_) * 1024 + h * 64;
        LAS unsigned char* scr = lds + SCAN_SCR_OFF + pw * SCR_BYTES;
        __syncthreads();
        if (tid < 192) par[tid] = (tid < 64 ? p.in[I_KK] : tid < 128 ? p.in[I_KA] : p.in[I_RK])[h * 64 + (tid & 63)];
        __syncthreads();
        if (wave >= 4) { scan_load(cur, Rb, Wb, Kb, Vb, Ab, hbase + (size_t)(pw * 16) * 1024, lane); scan_load(nxt, Rb, Wb, Kb, Vb, Ab, hbase + (size_t)((4 + pw) * 16) * 1024, lane);
                         scan_produce(cur, lds + pw * PK_BYTES, scr, lane, kkg, kag, rkg, bong + (size_t)(pw * 16) * 16); cur = nxt; }
        __syncthreads();
        const f32x4 z4 = {0.f, 0.f, 0.f, 0.f};
        f32x4 G[4] = {z4, z4, z4, z4};
        for (int R = 0; R < SEQ_ / 64; ++R) {
            if (wave < 4) {
#pragma unroll 1
                for (int qq = 0; qq < 4; ++qq) {
                    const LAS unsigned char* pk = lds + ((R & 1) * 4 + qq) * PK_BYTES;
                    const s16x4 vt = *(const LAS s16x4*)(pk + PK_VT + (16 * wave + fr) * 32 + wave * 32 + g * 8);
                    s16x4 Gb[4];
#pragma unroll
                    for (int kb = 0; kb < 4; ++kb) Gb[kb] = cvt4(G[kb]);
                    f32x4 PT = MFMA16(*(const LAS s16x4*)(pk + PK_NH + fr * SM_ + g * 8), vt, z4);
                    f32x4 OT = MFMA16(*(const LAS s16x4*)(pk + PK_MK + fr * SM_ + g * 8), vt, z4);
#pragma unroll
                    for (int kb = 0; kb < 4; ++kb) {
                        PT = MFMA16(*(const LAS s16x4*)(pk + PK_QH + fr * RS_ + (16 * kb + 4 * g) * 2), Gb[kb], PT);
                        OT = MFMA16(*(const LAS s16x4*)(pk + PK_RT + fr * RS_ + (16 * kb + 4 * g) * 2), Gb[kb], OT);
                    }
                    const s16x4 PTb = cvt4(PT);
                    OT = MFMA16(*(const LAS s16x4*)(pk + PK_MBN + fr * SM_ + g * 8), PTb, OT);
#pragma unroll
                    for (int kb = 0; kb < 4; ++kb) {
                        const f32x4 dc = *(const LAS f32x4*)(pk + PK_DC + (16 * kb + 4 * g) * 4);
                        f32x4 t = G[kb] * dc;
                        t = MFMA16(*(const LAS s16x4*)(pk + PK_BPN + (16 * kb + fr) * 32 + kb * 32 + g * 8), PTb, t);
                        G[kb] = MFMA16(*(const LAS s16x4*)(pk + PK_KP + (16 * kb + fr) * 32 + kb * 32 + g * 8), vt, t);
                    }
                    bf16_t* op = Ob + hbase + (size_t)((R * 4 + qq) * 16 + 4 * g) * 1024 + 16 * wave + fr;
#pragma unroll
                    for (int jj = 0; jj < 4; ++jj) { const float nb = dpp_mov<0xB1>(OT[jj]); const unsigned w2 = cvt2(OT[jj], nb); if ((fr & 1) == 0) *(unsigned*)(op + (size_t)jj * 1024) = w2; }
                }
            } else if (R + 1 < SEQ_ / 64) {
                if (R + 2 < SEQ_ / 64) scan_load(nxt, Rb, Wb, Kb, Vb, Ab, hbase + (size_t)(((R + 2) * 4 + pw) * 16) * 1024, lane);
                scan_produce(cur, lds + (((R + 1) & 1) * 4 + pw) * PK_BYTES, scr, lane, kkg, kag, rkg, bong + (size_t)(((R + 1) * 4 + pw) * 16) * 16); cur = nxt;
            }
            __syncthreads();
        }
    }
}
__device__ __forceinline__ void phase_post(const Params& p) {
    const bf16_t* Vb = (const bf16_t*)p.out; bf16_t* Gb = slot(p, 4);
    const bf16_t* Ob = slot(p, 0); const float* Bon = (const float*)(p.ws + WS_BON);
    const size_t total = (size_t)T_ * 256, stride = (size_t)GD_ * 512;
    const int tid0 = ltid();
    const int ch = (tid0 & 255) * 4;
    const f32x4 lg = *(const f32x4*)(p.in[I_LNXG] + ch), lb = *(const f32x4*)(p.in[I_LNXB] + ch);
    for (size_t g0 = (size_t)BI_ * 512 + tid0; g0 < total; g0 += 2 * stride) {
        u32x2 o2[2]; u32x2 uv2[2], ug2[2]; float bs2[2]; bool ok[2];
#pragma unroll
        for (int q = 0; q < 2; ++q) { const size_t gid = g0 + q * stride; ok[q] = gid < total; const size_t eo = (ok[q] ? gid : g0) * 4;
            o2[q] = *(const u32x2*)(Ob + eo); uv2[q] = *(const u32x2*)(Vb + eo); ug2[q] = *(const u32x2*)(Gb + eo); bs2[q] = Bon[(ok[q] ? gid : g0) >> 4]; }
#pragma unroll
        for (int q = 0; q < 2; ++q) {
            const size_t gid = g0 + q * stride; const size_t eo = gid * 4;
            const f32x4 o = {bf_lo(o2[q].x), bf_hi(o2[q].x), bf_lo(o2[q].y), bf_hi(o2[q].y)}; const u32x2 uv = uv2[q], ug = ug2[q]; const float bs = bs2[q];
            const f32x4 v4 = {bf_lo(uv.x), bf_hi(uv.x), bf_lo(uv.y), bf_hi(uv.y)}, g4 = {bf_lo(ug.x), bf_hi(ug.x), bf_lo(ug.y), bf_hi(ug.y)};
            float s = o[0] + o[1] + o[2] + o[3];
            s += dpp_mov<0xB1>(s); s += dpp_mov<0x4E>(s); s += dpp_mov<0x141>(s); s += dpp_mov<0x140>(s);
            const float mean = s * (1.f / 64.f);
            const f32x4 d = o - mean; float qq = d[0] * d[0] + d[1] * d[1] + d[2] * d[2] + d[3] * d[3];
            qq += dpp_mov<0xB1>(qq); qq += dpp_mov<0x4E>(qq); qq += dpp_mov<0x141>(qq); qq += dpp_mov<0x140>(qq);
            const float rstd = rsqrtf(qq * (1.f / 64.f) + 64e-5f);
            const f32x4 y = (d * rstd * lg + lb + bs * v4) * g4;
            u32x2 w; w.x = cvt_pk_bf16(y[0], y[1]); w.y = cvt_pk_bf16(y[2], y[3]);
            if (ok[q]) *(u32x2*)(Gb + eo) = w;
        }
    }
}

__device__ __forceinline__ void phase_conv(const Params& p, int l) {
    const bf16_t* Gt = slot(p, 1); bf16_t* Vl = slot(p, 1) + (size_t)T_ * FF_;
    const float* cw = p.in[I_CONVW] + (size_t)l * 3 * FF_; const float* cb = p.in[I_CONVB] + (size_t)l * FF_;
    constexpr int CH = FF_ / 8, RUN = 32;
    const int total = (T_ / RUN) * CH;
    const int tid0 = ltid();
    for (int id = BI_ * 512 + tid0; id < total; id += GD_ * 512) {
        const int cc = (id % CH) * 8, t0 = (id / CH) * RUN;
        float w0[8], w1[8], w2[8], bb[8], g1[8], g2[8];
#pragma unroll
        for (int e = 0; e < 8; ++e) { w0[e] = cw[cc + e]; w1[e] = cw[FF_ + cc + e]; w2[e] = cw[2 * FF_ + cc + e]; bb[e] = cb[cc + e]; g1[e] = 0.f; g2[e] = 0.f; }
        if ((t0 & (SEQ_ - 1)) != 0) {
            const u32x4 a = *(const u32x4*)(Gt + (size_t)(t0 - 1) * FF_ + cc), b = *(const u32x4*)(Gt + (size_t)(t0 - 2) * FF_ + cc);
            g1[0] = bf_lo(a.x); g1[1] = bf_hi(a.x); g1[2] = bf_lo(a.y); g1[3] = bf_hi(a.y); g1[4] = bf_lo(a.z); g1[5] = bf_hi(a.z); g1[6] = bf_lo(a.w); g1[7] = bf_hi(a.w);
            g2[0] = bf_lo(b.x); g2[1] = bf_hi(b.x); g2[2] = bf_lo(b.y); g2[3] = bf_hi(b.y); g2[4] = bf_lo(b.z); g2[5] = bf_hi(b.z); g2[6] = bf_lo(b.w); g2[7] = bf_hi(b.w);
        }
        for (int r = 0; r < RUN; ++r) {
            const size_t o = (size_t)(t0 + r) * FF_ + cc;
            const u32x4 a = *(const u32x4*)(Gt + o), vv = *(const u32x4*)(Vl + o);
            float g0[8] = {bf_lo(a.x), bf_hi(a.x), bf_lo(a.y), bf_hi(a.y), bf_lo(a.z), bf_hi(a.z), bf_lo(a.w), bf_hi(a.w)};
            float v8[8] = {bf_lo(vv.x), bf_hi(vv.x), bf_lo(vv.y), bf_hi(vv.y), bf_lo(vv.z), bf_hi(vv.z), bf_lo(vv.w), bf_hi(vv.w)};
            float hh[8];
#pragma unroll
            for (int e = 0; e < 8; ++e) { const float cv = g2[e] * w0[e] + g1[e] * w1[e] + g0[e] * w2[e] + bb[e]; hh[e] = cv * sigmoidf_(cv) * v8[e]; g2[e] = g1[e]; g1[e] = g0[e]; }
            u32x4 w; w.x = cvt_pk_bf16(hh[0], hh[1]); w.y = cvt_pk_bf16(hh[2], hh[3]); w.z = cvt_pk_bf16(hh[4], hh[5]); w.w = cvt_pk_bf16(hh[6], hh[7]);
            *(u32x4*)(Vl + o) = w;
        }
    }
}

__device__ __forceinline__ void phase_sgu(const Params& p, LAS unsigned char* lds) {
    LAS float* stats = (LAS float*)lds;
    LAS unsigned short* vTb = (LAS unsigned short*)(lds + 1024);
    const bf16_t* U = slot(p, 1); const bf16_t* V = slot(p, 2); bf16_t* Go = slot(p, 3);
    const bf16_t* Ws = wsW(p, W_GS);
    const int tid = ltid(), wave = tid >> 6, lane = tid & 63, fr = lane & 15, fq = lane >> 4;
    const int ls = tid >> 2, dq = (tid & 3) * 16;
    for (int unit = BI_; unit < T_ / 128; unit += GD_) {
        const size_t t0 = (size_t)unit * 128;
        __syncthreads();
        { const int row = tid >> 2, q = tid & 3; const f32x2 pr = *(const f32x2*)(p.out + (t0 + row) * 8 + q * 2); float s = pr.x, ss = pr.y;
          s += __shfl_xor(s, 1, 64); s += __shfl_xor(s, 2, 64); ss += __shfl_xor(ss, 1, 64); ss += __shfl_xor(ss, 2, 64);
          const float mean = s * (1.f / 1024.f), var = fmaxf(ss * (1.f / 1024.f) - mean * mean, 0.f);
          if (q == 0) { stats[row * 2] = mean; stats[row * 2 + 1] = rsqrtf(var + 1e-5f); } }
        const bf16_t* vrow = V + (t0 + ls) * 1024 + dq;
        u32x4 raw0 = *(const u32x4*)(vrow), raw1 = *(const u32x4*)(vrow + 8);
        f32x4 lgv[4], lbv[4];
#pragma unroll
        for (int i = 0; i < 4; ++i) { lgv[i] = *(const f32x4*)(p.in[I_GLNG] + dq + 4 * i); lbv[i] = *(const f32x4*)(p.in[I_GLNB] + dq + 4 * i); }
        __syncthreads();
        const float mean = stats[ls * 2], rstd = stats[ls * 2 + 1];
        const int t = 16 * wave + fr;
        for (int g = 0; g < 16; ++g) {
            LAS unsigned short* vT = vTb + (g & 1) * (64 * 136);
            u32x2 uu[4];
#pragma unroll
            for (int n = 0; n < 4; ++n) uu[n] = *(const u32x2*)(U + (t0 + t) * 1024 + g * 64 + n * 16 + fq * 4);
            const int kmax = (16 * wave + 15) >> 5;
            bf16x8 afv[4];
#pragma unroll
            for (int kk = 0; kk < 4; ++kk) if (kk <= kmax) afv[kk] = *(const bf16x8*)(Ws + ((size_t)g * 128 + 16 * wave + fr) * 128 + kk * 32 + fq * 8);
            const float bias = p.in[I_GBS][g * 128 + t];
            {
#pragma unroll
              for (int i = 0; i < 2; ++i) { const u32x4 a = i ? raw1 : raw0;
                  const float f[8] = {bf_lo(a.x), bf_hi(a.x), bf_lo(a.y), bf_hi(a.y), bf_lo(a.z), bf_hi(a.z), bf_lo(a.w), bf_hi(a.w)};
#pragma unroll
                  for (int e = 0; e < 8; ++e) vT[(dq + i * 8 + e) * 136 + ls] = bf1((f[e] - mean) * rstd * lgv[i * 2 + (e >> 2)][e & 3] + lbv[i * 2 + (e >> 2)][e & 3]); } }
            if (g + 1 < 16) { raw0 = *(const u32x4*)(vrow + (g + 1) * 64); raw1 = *(const u32x4*)(vrow + (g + 1) * 64 + 8);
#pragma unroll
                for (int i = 0; i < 4; ++i) { lgv[i] = *(const f32x4*)(p.in[I_GLNG] + (g + 1) * 64 + dq + 4 * i); lbv[i] = *(const f32x4*)(p.in[I_GLNB] + (g + 1) * 64 + dq + 4 * i); } }
            asm volatile("s_waitcnt lgkmcnt(0)" ::: "memory"); __builtin_amdgcn_s_barrier(); asm volatile("" ::: "memory");
            f32x4 acc[4];
#pragma unroll
            for (int n = 0; n < 4; ++n) acc[n] = (f32x4){0.f, 0.f, 0.f, 0.f};
#pragma unroll
            for (int kk = 0; kk < 4; ++kk) if (kk <= kmax) {
#pragma unroll
                for (int n = 0; n < 4; ++n) { const bf16x8 bfr = *(const LAS bf16x8*)(vT + (n * 16 + fr) * 136 + kk * 32 + fq * 8);
                    acc[n] = __builtin_amdgcn_mfma_f32_16x16x32_bf16(bfr, afv[kk], acc[n], 0, 0, 0); }
            }
            {
#pragma unroll
              for (int n = 0; n < 4; ++n) { const size_t o = (t0 + t) * 1024 + g * 64 + n * 16 + fq * 4;
                  u32x2 w; w.x = cvt_pk_bf16(bf_lo(uu[n].x) * (acc[n][0] + bias), bf_hi(uu[n].x) * (acc[n][1] + bias)); w.y = cvt_pk_bf16(bf_lo(uu[n].y) * (acc[n][2] + bias), bf_hi(uu[n].y) * (acc[n][3] + bias));
                  *(u32x2*)(Go + o) = w; } }
        }
    }
}

#define XB_TMO      128
#define XB_XCNT(j)  (256  + 64 * (j))
#define XB_XSUB(j)  (1280 + 64 * (j))
#define XB_XGEN(j)  (2304 + 64 * (j))
#define XB_TOP      3328
#define XB_TOPGEN   3392
#define XCD_BAR_WORDS 3456
#define XB_SPIN_CAP (1u << 18)

__device__ __forceinline__ unsigned xb_ld(unsigned* p)              { return __hip_atomic_load(p, __ATOMIC_RELAXED, __HIP_MEMORY_SCOPE_AGENT); }
__device__ __forceinline__ unsigned xb_add(unsigned* p, unsigned v) { return __hip_atomic_fetch_add(p, v, __ATOMIC_RELAXED, __HIP_MEMORY_SCOPE_AGENT); }
__device__ __forceinline__ unsigned xb_xcc_id() { return (unsigned)__builtin_amdgcn_s_getreg((3 << 11) | 20) & 0xFu; }
#define XB_SPIN(cond, bar) do { unsigned _sp = 0; while (cond) { __builtin_amdgcn_s_sleep(1); \
    if ((++_sp & 255u) == 0u) { if (xb_ld(&(bar)[XB_TMO])) break; if (_sp > XB_SPIN_CAP) { atomicAdd(&(bar)[XB_TMO], 1u); break; } } } } while (0)

struct XcdBarrier {
    unsigned* bar; unsigned x;
    volatile LAS unsigned* st;
};

__device__ __forceinline__ XcdBarrier xcd_barrier_post(unsigned* bar, volatile LAS unsigned* st) {
    XcdBarrier b; b.bar = bar; b.x = xb_xcc_id(); b.st = st;
    if (threadIdx.x == 0) (void)xb_add(&bar[XB_XCNT(b.x)], 1u);
    return b;
}
__device__ __forceinline__ void xcd_barrier_complete(unsigned* bar, unsigned x, unsigned& nloc, unsigned& nx) {
    const unsigned G = gridDim.x * gridDim.y * gridDim.z;
    unsigned sum, cnt, mine, sp = 0u;
    for (;;) {
        sum = 0u; cnt = 0u; mine = 0u;
#pragma unroll
        for (unsigned j = 0; j < 16; ++j) { const unsigned c = xb_ld(&bar[XB_XCNT(j)]); sum += c; cnt += (c > 0u) ? 1u : 0u; mine = (j == x) ? c : mine; }
        if (sum == G) break;
        __builtin_amdgcn_s_sleep(1);
        if ((++sp & 255u) == 0u) { if (xb_ld(&bar[XB_TMO])) break; if (sp > XB_SPIN_CAP) { atomicAdd(&bar[XB_TMO], 1u); break; } }
    }
    nloc = mine > 0u ? mine : 1u; nx = cnt > 0u ? cnt : 1u;
}

__device__ __forceinline__ void xcd_barrier(const XcdBarrier& b) {
    asm volatile("s_waitcnt vmcnt(0)" ::: "memory");
    __syncthreads();
    if (threadIdx.x == 0) {
        unsigned* bar = b.bar;
        __builtin_amdgcn_s_waitcnt(0);
        unsigned nloc = b.st[0], nx = b.st[1];
        if (nloc == 0u) { xcd_barrier_complete(bar, b.x, nloc, nx); b.st[0] = nloc; b.st[1] = nx; }
        const unsigned old = xb_add(&bar[XB_XSUB(b.x)], 1u);
        const unsigned gen = old / nloc;
        if (old + 1u == (gen + 1u) * nloc) {
            __builtin_amdgcn_fence(__ATOMIC_RELEASE, "agent");
            asm volatile("s_waitcnt vmcnt(0)" ::: "memory");
            const unsigned og = xb_add(&bar[XB_TOP], 1u);
            const unsigned tg = og / nx;
            if (og + 1u == (tg + 1u) * nx) xb_add(&bar[XB_TOPGEN], 1u);
            else XB_SPIN(xb_ld(&bar[XB_TOPGEN]) == tg, bar);
            __builtin_amdgcn_fence(__ATOMIC_ACQUIRE, "agent");
            xb_add(&bar[XB_XGEN(b.x)], 1u);
            asm volatile("s_waitcnt vmcnt(0)" ::: "memory");
        } else {
            XB_SPIN(xb_ld(&bar[XB_XGEN(b.x)]) == gen, bar);
            __builtin_amdgcn_fence(__ATOMIC_ACQUIRE, "agent");
            asm volatile("s_waitcnt vmcnt(0)" ::: "memory");
        }
    }
    __syncthreads();
}

__device__ __forceinline__ pg8::Gemm mk_gemm(const bf16_t* A, const bf16_t* Bt, int lda, int ldb, int K, int nM, int nN) {
    pg8::Gemm g; g.A = A; g.Bt = Bt; g.lda = lda; g.ldb = ldb; g.K = K; g.nM = nM; g.nN = nN; g.nZ = 1; g.zdiv = 1; g.zA1 = g.zA2 = g.zB1 = g.zB2 = 0; g.ksplit = 1 << 30; g.adelta = 0; g.ovl = 0; g.koffpn = 1 << 30; g.koff = 0; g.pm0 = 0; return g;
}
__device__ __forceinline__ pg8::EpiBfData mk_epi(bf16_t* O, int ldc) {
    pg8::EpiBfData e; e.O = O; e.ldc = ldc; e.zdiv = 1; e.zO1 = e.zO2 = 0; e.split_cols = 0; e.split_stride = 0; e.p0 = nullptr; e.p1 = nullptr; e.scale = 1.f; e.ss = nullptr; e.vs = nullptr; e.red = nullptr; return e;
}
constexpr int N_STEPS = 34;
__device__ __forceinline__ bool need_sync(int st) { return !(st == 2 || st == 3 || st == 5 || st == 6); }
__device__ __forceinline__ bool skip_step(int st) { return st == 1 || st == 2 || (MK_ONE_LAUNCH && (st == 19 || st == 32)) || st == 11 || st == 16 || st == 20 || st == 24 || st == 29 || st == 18 || st == 31; }
enum { K_NONE = 0, K_BF, K_LORA1, K_LORA2, K_GELU, K_RES, K_SOFTMAX, K_CONV };
struct Desc { pg8::Gemm g; pg8::EpiBfData e; const float* res; float* ssw; int kind; };
__device__ __forceinline__ void get_desc(const Params& p, int st, Desc& d) {
    const bf16_t* MEMN = (const bf16_t*)(p.ws + WS_MEMN); bf16_t* KM = (bf16_t*)(p.ws + WS_KM); bf16_t* VT = (bf16_t*)(p.ws + WS_VT);
    bf16_t* LMID = (bf16_t*)p.out + (size_t)T_ * 1024; float* SS = (float*)(p.ws + WS_SS);
    int l = 0, cs = -1;
    if (st >= 11 && st <= 19) cs = st - 11; else if (st >= 24 && st <= 32) { cs = st - 24; l = 1; }
    int kind = K_NONE; pg8::Gemm g = mk_gemm(nullptr, nullptr, 0, 0, 0, 0, 0); pg8::EpiBfData e = mk_epi(nullptr, 0);
    const float* res = nullptr; float* ssw = nullptr;
    if (st == 1) { g = mk_gemm(MEMN, wsW(p, W_CAKV), 1024, 1024, 1024, 8, 4); g.nZ = 2; g.zB1 = 2 * Mi; e = mk_epi(KM, 1024); e.zO1 = 2 * Mi; kind = K_BF; }
    else if (st == 2) { g = mk_gemm(wsW(p, W_CAKV + Mi), MEMN, 1024, 1024, 1024, 4, 1); g.nZ = 16; g.zdiv = 8; g.zA1 = 2 * Mi; g.zB2 = 256 * 1024;
                        e = mk_epi(VT, 256); e.zdiv = 8; e.zO1 = 2 * Mi; e.zO2 = 1024 * 256; kind = K_BF; }
    else if (st == 4) { g = mk_gemm(slot(p, 2), wsW(p, W_RKV), 1024, 1024, 1024, 256, 4); g.nZ = 2; g.zA1 = (long)(SLOT / 2); g.zB1 = (long)Mi; e = mk_epi(slot(p, 5), 1024); e.zO1 = (long)(SLOT / 2); kind = K_BF; }
    else if (st == 5) { g = mk_gemm(slot(p, 4), wsW(p, W_RKV + 2 * Mi), 1024, 1024, 1024, 256, 4); e = mk_epi((bf16_t*)p.out, 1024); kind = K_BF; }
    else if (st == 6) { g = mk_gemm(slot(p, 2), wsW(p, W_L1), 1024, 2048, 2048, 256, 1); g.ksplit = 16; g.adelta = -(long)SLOT - 2048; e = mk_epi(LMID, 256); kind = K_LORA1; }
    else if (st == 7) { g = mk_gemm(LMID, wsW(p, W_L2), 256, 256, 128, 256, 12); g.koffpn = 8; g.koff = 128;   e = mk_epi(slot(p, 2), 1024); e.split_cols = 1024; e.split_stride = (long)(SLOT / 2); e.p0 = p.in[I_W0]; e.p1 = p.in[I_A0]; kind = K_LORA2; }
    else if (st == 10) { g = mk_gemm(slot(p, 4), wsW(p, W_RWO), 1024, 1024, 1024, 256, 4); res = p.in[I_X]; ssw = SS; kind = K_RES; }
    else if (cs == 1) { g = mk_gemm(slot(p, 0), wsW(p, W_CAQ + l * Mi), 1024, 1024, 1024, 256, 4); e = mk_epi(slot(p, 1), 1024); e.scale = 0.0625f; e.ss = SS + (l ? 3 : 0) * 4 * T_; kind = K_BF; }
    else if (cs == 2) { g = mk_gemm(slot(p, 1), KM + (size_t)l * 2 * Mi, 1024, 1024, 256, 32, 1); g.nZ = 32; g.zdiv = 4; g.zA1 = (long)SEQ_ * 1024; g.zA2 = 256; g.zB1 = 256 * 1024; g.zB2 = 256; kind = K_SOFTMAX; }
    else if (cs == 3) { g = mk_gemm(slot(p, 2), VT + (size_t)l * 2 * Mi, 1024, 256, 256, 32, 1); g.nZ = 32; g.zdiv = 4; g.zA1 = (long)SEQ_ * 1024; g.zA2 = 256; g.zB1 = 1024 * 256; g.zB2 = 256 * 256;
                        e = mk_epi(slot(p, 3), 1024); e.zdiv = 4; e.zO1 = (long)SEQ_ * 1024; e.zO2 = 256; kind = K_BF; }
    else if (cs == 4) { g = mk_gemm(slot(p, 3), wsW(p, W_CAO + l * Mi), 1024, 1024, 1024, 256, 4); ssw = SS + (l ? 4 : 1) * 4 * T_; kind = K_RES; }
    else if (cs == 6) { g = mk_gemm(slot(p, 0), wsW(p, W_UP + (size_t)l * 5632 * 1024), 1024, 1024, 1024, 264, 22); g.ovl = 1; e.ss = SS + (l ? 4 : 1) * 4 * T_; e.p0 = p.in[I_CONVW] + (size_t)l * 3 * FF_; e.p1 = p.in[I_CONVB] + (size_t)l * FF_; kind = K_CONV; }
    else if (cs == 8) { g = mk_gemm(slot(p, 1), wsW(p, W_DOWN + (size_t)l * 2816 * 1024), FF_, FF_, FF_, 256, 4); if (l == 0) ssw = SS + 2 * 4 * T_; kind = K_RES; }
    else if (st == 21) { g = mk_gemm(slot(p, 0), wsW(p, W_GIN), 1024, 1024, 1024, 256, 8); e = mk_epi(slot(p, 1), 1024); e.split_cols = 1024; e.split_stride = (long)(SLOT / 2); e.ss = SS + 2 * 4 * T_; kind = K_GELU; }
    else if (st == 23) { g = mk_gemm(slot(p, 3), wsW(p, W_GOUT), 1024, 1024, 1024, 256, 4); ssw = SS + 3 * 4 * T_; kind = K_RES; }
    d.g = g; d.e = e; d.res = res; d.ssw = ssw; d.kind = kind;
}
namespace pg8 {
template <int OP> struct MakeEpi<EpiBf<OP>> { static __device__ __forceinline__ EpiBf<OP> make(const Params& p, int st, LAS unsigned char* lds) { Desc d; get_desc(p, st, d); EpiBf<OP> E; (EpiBfData&)E = d.e; E.red = (LAS float*)(lds + EXTRA_OFF); E.vs = (OP == OP_GELU) ? p.out : nullptr; return E; } };
template <> struct MakeEpi<EpiRes> { static __device__ __forceinline__ EpiRes make(const Params& p, int st, LAS unsigned char* lds) { Desc d; get_desc(p, st, d); return EpiRes{d.res, slot(p, 0), d.ssw, 1024, (LAS float*)(lds + EXTRA_OFF)}; } };
template <> struct MakeEpi<EpiConv> { static __device__ __forceinline__ EpiConv make(const Params& p, int st, LAS unsigned char* lds) { Desc d; get_desc(p, st, d); return EpiConv{slot(p, 1), d.e.p0, d.e.p1, d.e.ss, (LAS float*)(lds + EXTRA_OFF)}; } };
template <> struct MakeEpi<EpiSoftmax> { static __device__ __forceinline__ EpiSoftmax make(const Params& p, int, LAS unsigned char* lds) { return EpiSoftmax{slot(p, 2), (LAS float*)(lds + EXTRA_OFF)}; } };
}

__global__ void __launch_bounds__(512) mega(Params p) {
    extern __shared__ __attribute__((aligned(16))) unsigned char lds_raw[];
    LAS unsigned char* lds = (LAS unsigned char*)lds_raw;
    cg::grid_group grid = cg::this_grid();
#if MK_ONE_LAUNCH
    volatile LAS unsigned* xst = (volatile LAS unsigned*)(lds + LDS_BYTES - 64);
    if (threadIdx.x == 0) { xst[0] = 0u; xst[1] = 0u; }
    __syncthreads();
    const XcdBarrier xbar = xcd_barrier_post((unsigned*)(p.ws + WS_BAR), xst);
    for (int st = p.ph_lo; st < p.ph_hi; ++st) {
      if (skip_step(st)) continue;
      const int reps = 1 + (int)(((unsigned long long)(REP_MASK) >> st) & 1ull);
      for (int rep = 0; rep < reps; ++rep) {
        if ((st > p.ph_lo && need_sync(st)) || rep > 0) { if (st == 4 && rep == 0) grid.sync(); else xcd_barrier(xbar); }
#else
    { { const int st = p.ph_lo;
#endif
        const int l = (st >= 24) ? 1 : 0;
        if (st == 0) phase_prologue(p, lds);
        else if (st == 3) phase_r0(p);
        else if (st == 8) { if (BI_ < 128 || GD_ <= 128) phase_scan(p, lds); if (GD_ <= 128) { phase_convert_late(p, lds, BI_, GD_); __syncthreads();
                                 Desc d1; get_desc(p, 1, d1); pg8::gemm_phase<pg8::EpiBf<pg8::OP_NONE>, false>(lds, d1.g, p, 1);
                                 Desc d2; get_desc(p, 2, d2); pg8::gemm_phase<pg8::EpiBf<pg8::OP_NONE>, false>(lds, d2.g, p, 2); }
                            else if (BI_ >= 128) { phase_convert_late(p, lds, BI_ - 128, GD_ - 128); __syncthreads();
                                 Desc d1; get_desc(p, 1, d1); pg8::gemm_phase<pg8::EpiBf<pg8::OP_NONE>, false>(lds, d1.g, p, 1, GD_ - 128, BI_ - 128);
                                 Desc d2; get_desc(p, 2, d2); pg8::gemm_phase<pg8::EpiBf<pg8::OP_NONE>, false>(lds, d2.g, p, 2, GD_ - 128, BI_ - 128); } }
        else if (st == 9) phase_post(p);
        else if (st == 22) phase_sgu(p, lds);
        else if (st == 33) phase_final(slot(p, 0), p.out, p.in[I_NFIN]);
        else {
            Desc d; get_desc(p, st, d);
            if (d.kind == K_BF) pg8::gemm_phase<pg8::EpiBf<pg8::OP_NONE>, false>(lds, d.g, p, st);
            else if (d.kind == K_LORA1) pg8::gemm_phase<pg8::EpiBf<pg8::OP_LORA1>, true>(lds, d.g, p, st);
            else if (d.kind == K_LORA2) pg8::gemm_phase<pg8::EpiBf<pg8::OP_LORA2>, false>(lds, d.g, p, st);
            else if (d.kind == K_GELU) pg8::gemm_phase<pg8::EpiBf<pg8::OP_GELU>, false>(lds, d.g, p, st);
            else if (d.kind == K_RES) pg8::gemm_phase<pg8::EpiRes, false>(lds, d.g, p, st);
            else if (d.kind == K_SOFTMAX) pg8::gemm_phase<pg8::EpiSoftmax, false>(lds, d.g, p, st);
#if MK_ONE_LAUNCH
            else if (d.kind == K_CONV) {
                for (int half = 0; half < 1; ++half) {
                    pg8::Gemm gu = d.g; gu.nM = 264; gu.pm0 = 0; pg8::gemm_phase<pg8::EpiConv, false>(lds, gu, p, st);
                    xcd_barrier(xbar);
                    Desc dd; get_desc(p, st + 2, dd); pg8::Gemm gd = dd.g; gd.nM = 256; gd.pm0 = 0; pg8::gemm_phase<pg8::EpiRes, false>(lds, gd, p, st + 2);
                    if (half < 0) xcd_barrier(xbar);
                }
            }
#else
            else if (d.kind == K_CONV) pg8::gemm_phase<pg8::EpiConv, false>(lds, d.g, p, st);
#endif
        }
    } }
}

extern "C" void kernel_launch(void* const* d_in, const int* in_sizes, int n_in, void* d_out, int out_size, void* d_ws, size_t ws_size, hipStream_t stream) {
    static int grid = 0;
    if (grid == 0) {
        int dev = 0, cus = 0, per_cu = 0;
        (void)hipGetDevice(&dev); (void)hipDeviceGetAttribute(&cus, hipDeviceAttributeMultiprocessorCount, dev);
        if (hipFuncSetAttribute((const void*)mega, hipFuncAttributeMaxDynamicSharedMemorySize, LDS_BYTES) != hipSuccess) fprintf(stderr, "kernel_launch: hipFuncSetAttribute failed\n");
        if (hipOccupancyMaxActiveBlocksPerMultiprocessor(&per_cu, (const void*)mega, 512, LDS_BYTES) != hipSuccess || per_cu < 1) { fprintf(stderr, "kernel_launch: occupancy query gave %d\n", per_cu); per_cu = 1; }
        (void)hipGetLastError();
        grid = cus * per_cu; if (grid <= 0) grid = 256;
    }
    Params p{};
    for (int i = 0; i < 36; ++i) p.in[i] = (const float*)d_in[i];
    p.out = (float*)d_out; p.ws = (unsigned char*)d_ws;
#if MK_ONE_LAUNCH
    p.ph_lo = 0; p.ph_hi = N_STEPS;
    (void)hipMemsetAsync((char*)d_ws + WS_BAR, 0, 16384, stream);
    void* args[] = {&p};
    hipError_t e = hipLaunchCooperativeKernel((const void*)mega, dim3(grid), dim3(512), args, LDS_BYTES, stream);
    if (e != hipSuccess) fprintf(stderr, "cooperative launch failed: %s (grid %d)\n", hipGetErrorString(e), grid);
#else
    for (int st = 0; st < N_STEPS; ++st) { p.ph_lo = st; p.ph_hi = st + 1; hipLaunchKernelGGL(mega, dim3(grid), dim3(512), LDS_BYTES, stream, p); }
#endif
}
```
